# Optimizing an MI355X kernel written in HIP

```python
import math
import jax, jax.numpy as jnp
from jax import lax
import numpy as np

D_MODEL = 1024
BATCH = 16
SEQ = 4096
DEPTH = 1

DIFF_HEADS = 4
DIFF_HEAD_DIM = 64
DIFF_V_DIM = 2 * DIFF_HEAD_DIM
DIFF_ROT = DIFF_HEAD_DIM // 4
MLA_HEADS = 8
MLA_NOPE = 64
MLA_ROPE = 32
MLA_V = 64
MLA_Q_RANK = 384
MLA_KV_RANK = 256
D_FF = 4 * D_MODEL
N_BRANCHES = 2
ROPE_THETA = 500000.0
Q_BLOCK = 128
LN_EPS = 1e-5
RMS_EPS = 1e-6
MASK_VALUE = -1e30
ALPHA = (2.0 * DEPTH) ** 0.25
BETA = (8.0 * DEPTH) ** -0.25

DIFF_Q_COLS = DIFF_HEADS * 2 * DIFF_HEAD_DIM
DIFF_K_COLS = DIFF_HEADS * 2 * DIFF_HEAD_DIM
DIFF_V_COLS = DIFF_HEADS * DIFF_V_DIM
GATE_COLS = N_BRANCHES * D_MODEL
SPLIT_SIZES = (DIFF_Q_COLS, DIFF_K_COLS, DIFF_V_COLS, MLA_Q_RANK, MLA_KV_RANK, MLA_ROPE, GATE_COLS)
SPLIT_POINTS = tuple(int(s) for s in np.cumsum(SPLIT_SIZES)[:-1])
D_IN = int(sum(SPLIT_SIZES))
DIFF_OUT = DIFF_HEADS * DIFF_V_DIM
MLA_OUT = MLA_HEADS * MLA_V

kernel_name = "hybrid_diffattn_mla_gated_deepnorm"


def layer_norm(x, g, b):
    xf = x.astype(jnp.float32)
    mu = jnp.mean(xf, axis=-1, keepdims=True)
    var = jnp.mean(jnp.square(xf - mu), axis=-1, keepdims=True)
    return ((xf - mu) * lax.rsqrt(var + LN_EPS) * g.astype(jnp.float32) + b.astype(jnp.float32)).astype(x.dtype)


def rms_norm(x, g):
    xf = x.astype(jnp.float32)
    ms = jnp.mean(jnp.square(xf), axis=-1, keepdims=True)
    return (xf * lax.rsqrt(ms + RMS_EPS) * g.astype(jnp.float32)).astype(x.dtype)


def apply_rope(x, positions, rot_dim):
    half = rot_dim // 2
    inv_freq = jnp.power(ROPE_THETA, -jnp.arange(half, dtype=jnp.float32) / half)
    ang = positions.astype(jnp.float32)[:, :, None] * inv_freq
    ang = ang.reshape(ang.shape[:2] + (1,) * (x.ndim - 3) + (half,))
    cos = jnp.cos(ang).astype(x.dtype)
    sin = jnp.sin(ang).astype(x.dtype)
    x1 = x[..., :half]
    x2 = x[..., half:rot_dim]
    return jnp.concatenate([x1 * cos - x2 * sin, x2 * cos + x1 * sin, x[..., rot_dim:]], axis=-1)


def multi_map_causal_attention(q, k, v, map_w, scale):
    B, S, M, H, D = q.shape
    Dv = v.shape[-1]
    nb = S // Q_BLOCK
    qb = jnp.moveaxis(q.reshape(B, nb, Q_BLOCK, M, H, D), 1, 0)
    k_pos = jnp.arange(S)

    def one_block(args):
        i, q_i = args
        s = jnp.einsum('bqmhd,bkmhd->bmhqk', q_i, k).astype(jnp.float32) * scale
        q_pos = i * Q_BLOCK + jnp.arange(Q_BLOCK)
        mask = k_pos[None, :] <= q_pos[:, None]
        p = jax.nn.softmax(jnp.where(mask, s, MASK_VALUE), axis=-1)
        p = jnp.einsum('mh,bmhqk->bhqk', map_w.astype(jnp.float32), p)
        return jnp.einsum('bhqk,bkhd->bqhd', p.astype(v.dtype), v)

    out = lax.map(one_block, (jnp.arange(nb), qb))
    return jnp.moveaxis(out, 0, 1).reshape(B, S, H, Dv)


def token_mixer(x, positions, w_in, gate_b, diff_lambda, diff_subln_g, mla_q_norm_g, w_uq,
                mla_kv_norm_g, w_ukv, w_o_diff, w_o_mla, w_out, lambda_init):
    B, S, _ = x.shape
    z = jnp.einsum('bsd,de->bse', x, w_in)
    dq, dk, dv, cq, ckv, kr, gates = jnp.split(z, SPLIT_POINTS, axis=-1)

    dq = apply_rope(dq.reshape(B, S, DIFF_HEADS, 2, DIFF_HEAD_DIM), positions, DIFF_ROT).swapaxes(2, 3)
    dk = apply_rope(dk.reshape(B, S, DIFF_HEADS, 2, DIFF_HEAD_DIM), positions, DIFF_ROT).swapaxes(2, 3)
    dv = dv.reshape(B, S, DIFF_HEADS, DIFF_V_DIM)
    lam = diff_lambda.astype(jnp.float32)
    lam_full = jnp.exp(jnp.sum(lam[0] * lam[1])) - jnp.exp(jnp.sum(lam[2] * lam[3])) + lambda_init
    ones_h = jnp.ones((DIFF_HEADS,), jnp.float32)
    map_w = jnp.stack([ones_h, -lam_full * ones_h])
    o_diff = multi_map_causal_attention(dq, dk, dv, map_w, DIFF_HEAD_DIM ** -0.5)
    o_diff = rms_norm(o_diff, diff_subln_g) * (1.0 - lambda_init)
    o_diff = o_diff.reshape(B, S, DIFF_OUT)

    q = jnp.einsum('bsr,re->bse', rms_norm(cq, mla_q_norm_g), w_uq).reshape(B, S, MLA_HEADS, MLA_NOPE + MLA_ROPE)
    q = jnp.concatenate([q[..., :MLA_NOPE], apply_rope(q[..., MLA_NOPE:], positions, MLA_ROPE)], axis=-1)
    kv = jnp.einsum('bsr,re->bse', rms_norm(ckv, mla_kv_norm_g), w_ukv).reshape(B, S, MLA_HEADS, MLA_NOPE + MLA_V)
    k_nope, v = kv[..., :MLA_NOPE], kv[..., MLA_NOPE:]
    k_rope = apply_rope(kr[:, :, None, :], positions, MLA_ROPE)
    k = jnp.concatenate([k_nope, jnp.broadcast_to(k_rope, (B, S, MLA_HEADS, MLA_ROPE))], axis=-1)
    o_mla = multi_map_causal_attention(q[:, :, None], k[:, :, None], v,
                                       jnp.ones((1, MLA_HEADS), jnp.float32),
                                       (MLA_NOPE + MLA_ROPE) ** -0.5)
    o_mla = o_mla.reshape(B, S, MLA_OUT)

    g = jax.nn.sigmoid(gates.reshape(B, S, N_BRANCHES, D_MODEL) + gate_b)
    y = g[:, :, 0] * jnp.einsum('bse,ed->bsd', o_diff, w_o_diff) \
        + g[:, :, 1] * jnp.einsum('bse,ed->bsd', o_mla, w_o_mla)
    return jnp.einsum('bsd,de->bse', y, w_out)


def squared_relu_mlp(x, w_up, w_down):
    h = jnp.square(jax.nn.relu(jnp.einsum('bsd,df->bsf', x, w_up)))
    return jnp.einsum('bsf,fd->bsd', h, w_down)


def setup_inputs(seed: int = 0) -> dict:
    key = jax.random.key(seed)
    ks = jax.random.split(key, 20)
    f32 = jnp.float32

    def nrm(k, shape, scale):
        return jax.random.normal(k, shape, f32) * scale

    def gain(k, shape):
        return 1.0 + 0.02 * jax.random.normal(k, shape, f32)

    x = jax.random.normal(ks[0], (BATCH, SEQ, D_MODEL), f32)
    offsets = jax.random.randint(ks[1], (BATCH, 1), 0, 1024, dtype=jnp.int32)
    positions = offsets + jnp.arange(SEQ, dtype=jnp.int32)[None, :]
    return {
        "x": x,
        "positions": positions,
        "w_in": nrm(ks[2], (DEPTH, D_MODEL, D_IN), D_MODEL ** -0.5),
        "gate_b": nrm(ks[3], (DEPTH, N_BRANCHES, D_MODEL), 0.02),
        "diff_lambda": nrm(ks[4], (DEPTH, 4, DIFF_HEAD_DIM), 0.1),
        "diff_subln_g": gain(ks[5], (DEPTH, DIFF_V_DIM)),
        "mla_q_norm_g": gain(ks[6], (DEPTH, MLA_Q_RANK)),
        "w_uq": nrm(ks[7], (DEPTH, MLA_Q_RANK, MLA_HEADS * (MLA_NOPE + MLA_ROPE)), MLA_Q_RANK ** -0.5),
        "mla_kv_norm_g": gain(ks[8], (DEPTH, MLA_KV_RANK)),
        "w_ukv": nrm(ks[9], (DEPTH, MLA_KV_RANK, MLA_HEADS * (MLA_NOPE + MLA_V)), MLA_KV_RANK ** -0.5),
        "w_o_diff": nrm(ks[10], (DEPTH, DIFF_OUT, D_MODEL), BETA * DIFF_OUT ** -0.5),
        "w_o_mla": nrm(ks[11], (DEPTH, MLA_OUT, D_MODEL), BETA * MLA_OUT ** -0.5),
        "w_out": nrm(ks[12], (DEPTH, D_MODEL, D_MODEL), BETA * D_MODEL ** -0.5),
        "ln1_g": gain(ks[13], (DEPTH, D_MODEL)),
        "ln1_b": nrm(ks[14], (DEPTH, D_MODEL), 0.02),
        "w_up": nrm(ks[15], (DEPTH, D_MODEL, D_FF), D_MODEL ** -0.5),
        "w_down": nrm(ks[16], (DEPTH, D_FF, D_MODEL), BETA * D_FF ** -0.5),
        "ln2_g": gain(ks[17], (DEPTH, D_MODEL)),
        "ln2_b": nrm(ks[18], (DEPTH, D_MODEL), 0.02),
    }


def reference(x, positions, w_in, gate_b, diff_lambda, diff_subln_g, mla_q_norm_g, w_uq,
              mla_kv_norm_g, w_ukv, w_o_diff, w_o_mla, w_out, ln1_g, ln1_b, w_up, w_down,
              ln2_g, ln2_b):
    for l in range(DEPTH):
        lambda_init = 0.8 - 0.6 * math.exp(-0.3 * l)
        h = token_mixer(x, positions, w_in[l], gate_b[l], diff_lambda[l], diff_subln_g[l],
                        mla_q_norm_g[l], w_uq[l], mla_kv_norm_g[l], w_ukv[l],
                        w_o_diff[l], w_o_mla[l], w_out[l], lambda_init)
        x = layer_norm(ALPHA * x + h, ln1_g[l], ln1_b[l])
        x = layer_norm(ALPHA * x + squared_relu_mlp(x, w_up[l], w_down[l]), ln2_g[l], ln2_b[l])
    return x
```

```cpp
#include <hip/hip_runtime.h>
#include <hip/hip_cooperative_groups.h>
#include <hip/hip_bf16.h>
#include <cstdio>
#include <cstdint>
#include <cmath>
namespace cg = cooperative_groups;
namespace pg8 {
#define PG8_LAS __attribute__((address_space(3)))
typedef unsigned short bf16_t;
typedef short bf16x8 __attribute__((ext_vector_type(8)));
typedef float f32x4 __attribute__((ext_vector_type(4)));
typedef unsigned u32x4 __attribute__((ext_vector_type(4)));
constexpr int BM = 256, BK = 64, HALF = 128, HTB = HALF * BK * 2  , STAGE_BYTES = 8 * HTB, NXCD = 8, WGM = 8;

__host__ __device__ __forceinline__ int lds_byte(int r, int c) { const int st = (r >> 4) * 2 + (c >> 5), rr = r & 15, cc = c & 31, ob = rr * 64 + cc * 2; return st * 1024 + (ob ^ (((ob >> 9) & 1) << 5)); }
__host__ __device__ __forceinline__ void stage_rc(int b, int& R, int& C) { const int st = b / 1024, sb = b % 1024, swz = sb ^ (((sb >> 9) & 1) << 5); R = (st >> 1) * 16 + swz / 64; C = (st & 1) * 32 + (swz % 64) / 2; }
__host__ __device__ __forceinline__ int perm32(int rho) { const int n = rho >> 4, i = rho & 15; return 8 * (i >> 2) + 4 * n + (i & 3); }

struct Unit { int pm, pn; };
struct Gemm { const bf16_t* A; const bf16_t* Bt; int M, N, K; };

struct StaticOrder {
    int nM, nN, nwg, G, c;
    __host__ __device__ void init(int M, int N, int G_, int c_) { nM = M / BM; nN = N / BM; nwg = nM * nN; G = G_; c = c_; }
    __host__ __device__ bool next(int i, Unit& u) const {
        const long L = (long)i * G + c; if (L >= nwg) return false;
        int wgid = (int)L; { const int q = nwg / NXCD, r = nwg % NXCD, xcd = wgid % NXCD, off = wgid / NXCD; wgid = (xcd < r ? xcd * (q + 1) : r * (q + 1) + (xcd - r) * q) + off; }
        const int nig = WGM * nN, gid = wgid / nig, fm = gid * WGM, gsz = (nM - fm) < WGM ? (nM - fm) : WGM;
        u.pm = fm + ((wgid % nig) % gsz); u.pn = (wgid % nig) / gsz; return true;
    }
    __device__ __forceinline__ void a_ready(const Unit&) const {}
    __device__ __forceinline__ void done(const Unit&) const {}
};

typedef float f32x2c __attribute__((ext_vector_type(2))); typedef __bf16 bf16x2c __attribute__((ext_vector_type(2)));
__device__ __forceinline__ unsigned cvt_pk_bf16(float lo, float hi) { f32x2c v = {lo, hi}; bf16x2c b = __builtin_convertvector(v, bf16x2c); return __builtin_bit_cast(unsigned, b); }
typedef float f32x2 __attribute__((ext_vector_type(2)));
template <class Epi, class Sched, bool ALIGN_EPI = false, bool SP2 = false>
__device__ __forceinline__ void gemm_phase(PG8_LAS unsigned char* lds, const Gemm g, const Sched& S, const Epi& E, const int tid_in) {
    const int tid = tid_in, wid = __builtin_amdgcn_readfirstlane(tid >> 6), lane = tid & 63, wr = wid >> 2, wc = wid & 3, fr = lane & 15, fq = lane >> 4;
    const int K = g.K, nt = K / BK;
    unsigned voffA[2], voffB[2];
#pragma unroll
    for (int i = 0; i < 2; ++i) { int R, C; stage_rc(tid * 16 + i * 8192, R, C); const int Rb = Epi::PERM ? ((R & ~31) + perm32(R & 31)) : R;
        voffA[i] = (unsigned)(R * K + C) * 2u; voffB[i] = (unsigned)(Rb * K + C) * 2u; }
    const size_t kstep = (size_t)(BK * 2);
    const size_t hstep = (size_t)HALF * K * 2;
    const size_t tstep = 2 * hstep;
    const unsigned ldsw = (unsigned)wid * 1024u;
    const int aoff = lds_byte(wr * 64 + fr, fq * 8), boff = lds_byte(wc * 32 + fr, fq * 8);
#define PG8_SA(b, h) (((b) * 2 + (h)) * HTB)
#define PG8_SB(b, h) ((4 + (b) * 2 + (h)) * HTB)
#define PG8_STAGE(bufoff, gbase, voff) do { _Pragma("unroll") for (int _i = 0; _i < 2; ++_i) \
        __builtin_amdgcn_global_load_lds((const unsigned*)((const char*)(gbase) + (voff)[_i]), (PG8_LAS unsigned*)(lds + (bufoff) + ldsw + _i * 8192), 16, 0, 0); } while (0)
#define PG8_LDA(dst, b, h) do { _Pragma("unroll") for (int m = 0; m < 4; ++m) _Pragma("unroll") for (int k = 0; k < 2; ++k) dst[m][k] = *(const PG8_LAS bf16x8*)(lds + PG8_SA(b, h) + aoff + m * 2048 + k * 1024); } while (0)
#define PG8_LDB(dst, b, h) do { _Pragma("unroll") for (int n = 0; n < 2; ++n) _Pragma("unroll") for (int k = 0; k < 2; ++k) dst[n][k] = *(const PG8_LAS bf16x8*)(lds + PG8_SB(b, h) + boff + n * 2048 + k * 1024); } while (0)
#define PG8_MMA(ai, bj, At, Bt) do { __builtin_amdgcn_s_setprio(1); _Pragma("unroll") for (int m = 0; m < 4; ++m) _Pragma("unroll") for (int n = 0; n < 2; ++n) _Pragma("unroll") for (int k = 0; k < 2; ++k) \
        acc[ai][bj][m][n] = __builtin_amdgcn_mfma_f32_16x16x32_bf16(Bt[n][k], At[m][k], acc[ai][bj][m][n], 0, 0, 0); __builtin_amdgcn_s_setprio(0); } while (0)
#define PG8_WAIT_V(n) asm volatile("s_waitcnt vmcnt(" #n ")" ::: "memory")
#define PG8_WAIT_L(n) asm volatile("s_waitcnt lgkmcnt(" #n ")" ::: "memory")
#define PG8_BAR __builtin_amdgcn_s_barrier()
#define PG8_SCHED __builtin_amdgcn_sched_barrier(0)
    Unit cur, nxt; int ui = 0;
    if (!S.next(0, cur)) return;
    f32x4 acc[2][2][4][2];
#pragma unroll
    for (int a = 0; a < 2; ++a)
#pragma unroll
        for (int b = 0; b < 2; ++b)
#pragma unroll
            for (int m = 0; m < 4; ++m)
#pragma unroll
                for (int n = 0; n < 2; ++n) { float z_ = 0.f; asm volatile("" : "+v"(z_)); acc[a][b][m][n] = (f32x4){z_, z_, z_, z_}; }
    bf16x8 At[4][2], B0[2][2], B1[2][2];
    const char* cA = (const char*)g.A + (size_t)cur.pm * tstep; const char* cB = (const char*)g.Bt + (size_t)cur.pn * tstep;
    S.a_ready(cur);
    if constexpr (SP2) {
        PG8_STAGE(PG8_SB(0, 0), cB, voffB); PG8_STAGE(PG8_SB(0, 1), cB + hstep, voffB); PG8_STAGE(PG8_SA(0, 0), cA, voffA); PG8_STAGE(PG8_SA(0, 1), cA + hstep, voffA);
        if (wr == 1) PG8_BAR;
        PG8_WAIT_V(2); PG8_BAR;
        PG8_STAGE(PG8_SB(1, 0), cB + kstep, voffB); PG8_STAGE(PG8_SA(1, 0), cA + kstep, voffA); PG8_STAGE(PG8_SB(1, 1), cB + hstep + kstep, voffB);
        PG8_WAIT_V(6); PG8_BAR;
    } else {
        PG8_STAGE(PG8_SB(0, 0), cB, voffB); PG8_STAGE(PG8_SA(0, 0), cA, voffA); PG8_STAGE(PG8_SB(0, 1), cB + hstep, voffB); PG8_STAGE(PG8_SA(0, 1), cA + hstep, voffA);
        if (wr == 1) PG8_BAR;
        PG8_WAIT_V(4); PG8_BAR;
        PG8_STAGE(PG8_SB(1, 0), cB + kstep, voffB); PG8_STAGE(PG8_SA(1, 0), cA + kstep, voffA); PG8_STAGE(PG8_SB(1, 1), cB + hstep + kstep, voffB);
        PG8_WAIT_V(6); PG8_BAR;
    }
    for (;;) {
        const bool has_next = S.next(ui + 1, nxt);
        const char* nA = has_next ? (const char*)g.A + (size_t)nxt.pm * tstep : cA; const char* nB = has_next ? (const char*)g.Bt + (size_t)nxt.pn * tstep : cB;
        for (int t = 0; t < nt; t += 2) {
            if (E.mode == 3 && t == (nt >> 1)) E.mid(acc, cur, wr, wc, fr, fq);
            const bool last = (t == nt - 2);
            const char* a1 = cA + (size_t)(t + 1) * kstep;
            const char* a2 = last ? nA : cA + (size_t)(t + 2) * kstep; const char* b2 = last ? nB : cB + (size_t)(t + 2) * kstep;
            const char* a3 = a2 + kstep; const char* b3 = b2 + kstep;
            if (last && has_next) S.a_ready(nxt);
            if constexpr (SP2) {
            PG8_LDB(B0, 0, 0); PG8_LDB(B1, 0, 1); PG8_SCHED; PG8_LDA(At, 0, 0); PG8_STAGE(PG8_SA(1, 1), a1 + hstep, voffA);
            PG8_WAIT_V(8); PG8_WAIT_L(0); PG8_BAR; PG8_MMA(0, 0, At, B0); PG8_MMA(0, 1, At, B1); PG8_BAR; PG8_SCHED;
            PG8_LDA(At, 0, 1); PG8_STAGE(PG8_SB(0, 0), b2, voffB); PG8_STAGE(PG8_SB(0, 1), b2 + hstep, voffB); PG8_STAGE(PG8_SA(0, 0), a2, voffA);
            PG8_WAIT_V(8); PG8_WAIT_L(0); PG8_BAR; PG8_MMA(1, 0, At, B0); PG8_MMA(1, 1, At, B1); PG8_BAR; PG8_SCHED;
            PG8_LDB(B0, 1, 0); PG8_LDB(B1, 1, 1); PG8_SCHED; PG8_LDA(At, 1, 0); PG8_STAGE(PG8_SA(0, 1), a2 + hstep, voffA);
            PG8_WAIT_V(8); PG8_WAIT_L(0); PG8_BAR; PG8_MMA(0, 0, At, B0); PG8_MMA(0, 1, At, B1); PG8_BAR; PG8_SCHED;
            PG8_LDA(At, 1, 1); PG8_STAGE(PG8_SB(1, 0), b3, voffB); PG8_STAGE(PG8_SB(1, 1), b3 + hstep, voffB); PG8_STAGE(PG8_SA(1, 0), a3, voffA);
            PG8_WAIT_V(8); PG8_WAIT_L(0); PG8_BAR; PG8_MMA(1, 0, At, B0); PG8_MMA(1, 1, At, B1); PG8_BAR; PG8_SCHED;
            } else {
            PG8_LDB(B0, 0, 0); PG8_SCHED; PG8_LDA(At, 0, 0); PG8_STAGE(PG8_SA(1, 1), a1 + hstep, voffA);
            PG8_WAIT_L(8); PG8_BAR; PG8_WAIT_L(0); PG8_MMA(0, 0, At, B0); PG8_BAR; PG8_SCHED;
            PG8_LDB(B1, 0, 1); PG8_STAGE(PG8_SB(0, 0), b2, voffB);
            PG8_BAR; PG8_WAIT_L(0); PG8_MMA(0, 1, At, B1); PG8_BAR;
            PG8_LDA(At, 0, 1); PG8_STAGE(PG8_SA(0, 0), a2, voffA);
            PG8_BAR; PG8_WAIT_L(0); PG8_MMA(1, 0, At, B0); PG8_BAR; PG8_SCHED;
            PG8_STAGE(PG8_SB(0, 1), b2 + hstep, voffB);
            PG8_WAIT_V(6); PG8_BAR; PG8_MMA(1, 1, At, B1); PG8_BAR;
            PG8_LDB(B0, 1, 0); PG8_SCHED; PG8_LDA(At, 1, 0); PG8_STAGE(PG8_SA(0, 1), a2 + hstep, voffA);
            PG8_WAIT_L(8); PG8_BAR; PG8_WAIT_L(0); PG8_MMA(0, 0, At, B0); PG8_BAR; PG8_SCHED;
            PG8_LDB(B1, 1, 1); PG8_STAGE(PG8_SB(1, 0), b3, voffB);
            PG8_BAR; PG8_WAIT_L(0); PG8_MMA(0, 1, At, B1); PG8_BAR;
            PG8_LDA(At, 1, 1); PG8_STAGE(PG8_SA(1, 0), a3, voffA);
            PG8_BAR; PG8_WAIT_L(0); PG8_MMA(1, 0, At, B0); PG8_BAR; PG8_SCHED;
            PG8_STAGE(PG8_SB(1, 1), b3 + hstep, voffB);
            PG8_WAIT_V(6); PG8_BAR; PG8_MMA(1, 1, At, B1); PG8_BAR;
            }
        }
        if constexpr (ALIGN_EPI) { if (wr == 0) PG8_BAR; }
        if constexpr (!Epi::AFTER_DRAIN) { E(acc, cur, wr, wc, fr, fq); S.done(cur); }
        if (!has_next) break;
#pragma unroll
        for (int a = 0; a < 2; ++a)
#pragma unroll
            for (int b = 0; b < 2; ++b)
#pragma unroll
                for (int m = 0; m < 4; ++m)
#pragma unroll
                    for (int n = 0; n < 2; ++n) { float z_ = 0.f; asm volatile("" : "+v"(z_)); acc[a][b][m][n] = (f32x4){z_, z_, z_, z_}; }
        cur = nxt; cA = nA; cB = nB; ++ui;
        if constexpr (ALIGN_EPI) { if (wr == 1) PG8_BAR; }
    }
    PG8_WAIT_V(0);
    if constexpr (!ALIGN_EPI) { if (wr == 0) PG8_BAR; }
    PG8_BAR;
    if constexpr (Epi::AFTER_DRAIN) { E.fused(acc, cur, wr, wc, fr, fq, lds, wid, lane); S.done(cur); }
#undef PG8_SA
#undef PG8_SB
#undef PG8_STAGE
#undef PG8_LDA
#undef PG8_LDB
#undef PG8_MMA
#undef PG8_WAIT_V
#undef PG8_WAIT_L
#undef PG8_BAR
#undef PG8_SCHED
}
}

#define GAS __attribute__((address_space(1)))
#define LAS __attribute__((address_space(3)))
typedef unsigned short bf16;
typedef unsigned v4u __attribute__((ext_vector_type(4)));
typedef float f32x4 __attribute__((ext_vector_type(4)));
typedef short bf16x8 __attribute__((ext_vector_type(8)));
typedef short s16x4 __attribute__((ext_vector_type(4)));
typedef float f32x16 __attribute__((ext_vector_type(16)));

constexpr int NWAVES = 8;
constexpr int NB = 16, SEQ = 4096, NTOK = NB * SEQ, DMODEL = 1024, DIN = 4256, DINP = 4352, DFF = 4096;
constexpr float LOG2E = 1.4426950408889634f;
constexpr float C2D = 0.125f * LOG2E;
constexpr float C2M = 0.10206207261596577f * LOG2E;
constexpr float ALPHA = 1.189207115002721f;
constexpr float LN_EPS = 1e-5f, RMS_EPS = 1e-6f;
constexpr float LAMBDA_INIT = 0.2f;

constexpr size_t MiB = 1u << 20;
constexpr size_t WS_XB = 0, WS_DQ = 128 * MiB, WS_DK = 192 * MiB, WS_DV = 256 * MiB, WS_CQ = 320 * MiB, WS_CKV = 368 * MiB, WS_KR = 400 * MiB,
                 WS_G = 404 * MiB, WS_QM = 660 * MiB, WS_KV = 756 * MiB;
constexpr size_t WS_OD = 0, WS_OM = 64 * MiB, WS_Y = 128 * MiB, WS_X1 = 0, WS_X1B = 256 * MiB, WS_H = 384 * MiB;
constexpr size_t WS_WIN = 900 * MiB, WS_WUQ = 909 * MiB, WS_WUKV = 910 * MiB, WS_WOD = 911 * MiB, WS_WOM = 912 * MiB, WS_WOUT = 913 * MiB,
                 WS_WUP = 915 * MiB, WS_WDN = 923 * MiB, WS_TD = 931 * MiB, WS_TM = 935 * MiB, WS_SSQ = 943 * MiB, WS_O1 = 948 * MiB, WS_END = 980 * MiB;
constexpr size_t WS_CTL = 896 * MiB, CTL_BYTES = 16384;

constexpr int RING_BYTES = 131072, LDS_BYTES = 147456;

struct Params {
    const float* x; const int* pos; const float* w_in; const float* gate_b; const float* diff_lambda; const float* subln_g; const float* qn_g; const float* w_uq;
    const float* kvn_g; const float* w_ukv; const float* w_od; const float* w_om; const float* w_out; const float* ln1_g; const float* ln1_b; const float* w_up; const float* w_dn;
    const float* ln2_g; const float* ln2_b;
    float* out; unsigned char* ws; float invf[24]; int s_lo, s_hi;
};

__device__ __forceinline__ unsigned f2bf(float f) { unsigned u = __builtin_bit_cast(unsigned, f); return (u + 0x7fffu + ((u >> 16) & 1u)) >> 16; }
__device__ __forceinline__ unsigned pk2(float lo, float hi) { return f2bf(lo) | (f2bf(hi) << 16); }
__device__ __forceinline__ float bf2f(unsigned short h) { return __builtin_bit_cast(float, (unsigned)h << 16); }
__device__ __forceinline__ float shxl(float v, int m, int lane) { return __builtin_bit_cast(float, __builtin_amdgcn_ds_bpermute((lane ^ m) << 2, __builtin_bit_cast(int, v))); }
__device__ __forceinline__ float wave_sum(float v, int lane) {
#pragma unroll
    for (int o = 1; o < 64; o <<= 1) v += shxl(v, o, lane);
    return v;
}

struct Epi {
    static constexpr bool PERM = true, AFTER_DRAIN = false;
    int mode; const __attribute__((address_space(4))) Params* kp;
    __device__ __forceinline__ static void st8_nt(bf16* p, pg8::f32x4 v0, pg8::f32x4 v1) {
        pg8::u32x4 w; w.x = pg8::cvt_pk_bf16(v0[0], v0[1]); w.y = pg8::cvt_pk_bf16(v0[2], v0[3]); w.z = pg8::cvt_pk_bf16(v1[0], v1[1]); w.w = pg8::cvt_pk_bf16(v1[2], v1[3]);
        __builtin_nontemporal_store(w, (pg8::u32x4*)p);
    }
    __device__ __forceinline__ static void st8(bf16* p, pg8::f32x4 v0, pg8::f32x4 v1) {
        pg8::u32x4 w; w.x = pg8::cvt_pk_bf16(v0[0], v0[1]); w.y = pg8::cvt_pk_bf16(v0[2], v0[3]); w.z = pg8::cvt_pk_bf16(v1[0], v1[1]); w.w = pg8::cvt_pk_bf16(v1[2], v1[3]);
        *(pg8::u32x4*)p = w;
    }
    __device__ __forceinline__ static void ld8(const bf16* p, pg8::f32x4& v0, pg8::f32x4& v1) {
        const pg8::u32x4 w = *(const pg8::u32x4*)p;
        v0[0] = __builtin_bit_cast(float, w.x << 16); v0[1] = __builtin_bit_cast(float, w.x & 0xffff0000u); v0[2] = __builtin_bit_cast(float, w.y << 16); v0[3] = __builtin_bit_cast(float, w.y & 0xffff0000u);
        v1[0] = __builtin_bit_cast(float, w.z << 16); v1[1] = __builtin_bit_cast(float, w.z & 0xffff0000u); v1[2] = __builtin_bit_cast(float, w.w << 16); v1[3] = __builtin_bit_cast(float, w.w & 0xffff0000u);
    }
    __device__ __forceinline__ static float px(float v, int m, int lane) {
        const unsigned u = __builtin_bit_cast(unsigned, v);
        if (m == 32) { auto rr = __builtin_amdgcn_permlane32_swap(u, u, false, false); return __builtin_bit_cast(float, (lane & 32) ? (unsigned)rr[0] : (unsigned)rr[1]); }
        else { auto rr = __builtin_amdgcn_permlane16_swap(u, u, false, false); return __builtin_bit_cast(float, (lane & 16) ? (unsigned)rr[0] : (unsigned)rr[1]); }
    }
    __device__ __forceinline__ static pg8::f32x4 shx(pg8::f32x4 v, int m, int lane) { pg8::f32x4 r; r[0] = px(v[0], m, lane); r[1] = px(v[1], m, lane); r[2] = px(v[2], m, lane); r[3] = px(v[3], m, lane); return r; }
    __device__ __forceinline__ static void rope32(pg8::f32x4& v0, pg8::f32x4& v1, const float* trow, int fq, int lane) {
        const pg8::f32x4 q0 = shx(v0, 32, lane), q1 = shx(v1, 32, lane);
        const int i0 = 8 * (fq & 1); const float sg = fq < 2 ? -1.f : 1.f;
        const pg8::f32x4 c0 = *(const pg8::f32x4*)(trow + i0), c1 = *(const pg8::f32x4*)(trow + i0 + 4), s0 = *(const pg8::f32x4*)(trow + 16 + i0), s1 = *(const pg8::f32x4*)(trow + 16 + i0 + 4);
        v0 = v0 * c0 + (q0 * s0) * sg; v1 = v1 * c1 + (q1 * s1) * sg;
    }
    __device__ __forceinline__ void mid(pg8::f32x4 (&acc)[2][2][4][2], const pg8::Unit& u, int wr_, int wc_, int fr_, int fq_) const {
        using pg8::f32x4; using pg8::BM; using pg8::HALF;
        int wr = wr_, wc = wc_, fr = fr_, fq = fq_; asm volatile("" : "+s"(wr), "+s"(wc), "+v"(fr), "+v"(fq));
        unsigned char* const ws = kp->ws; const bf16* const G = (const bf16*)(ws + WS_G);
        const int row0 = u.pm * BM + wr * 64 + fr;
#pragma unroll
        for (int bj = 0; bj < 2; ++bj) { const int c0 = u.pn * BM + bj * HALF + wc * 32 + 8 * fq;
#pragma unroll
            for (int ai = 0; ai < 2; ++ai)
#pragma unroll
                for (int m = 0; m < 4; ++m) { const int row = row0 + ai * HALF + m * 16; f32x4 g0a, g0b, g1a, g1b;
                    ld8(G + (size_t)row * 2048 + c0, g0a, g0b); ld8(G + (size_t)row * 2048 + 1024 + c0, g1a, g1b);
#pragma unroll
                    for (int j = 0; j < 4; ++j) { acc[ai][bj][m][0][j] *= g0a[j] * __builtin_amdgcn_rcpf(g1a[j]); acc[ai][bj][m][1][j] *= g0b[j] * __builtin_amdgcn_rcpf(g1b[j]); } } }
    }
    __device__ __forceinline__ void operator()(const pg8::f32x4 (&acc)[2][2][4][2], const pg8::Unit& u, int wr_, int wc_, int fr_, int fq_) const {
        using pg8::f32x4; using pg8::BM; using pg8::HALF;
        int wr = wr_, wc = wc_, fr = fr_, fq = fq_; asm volatile("" : "+s"(wr), "+s"(wc), "+v"(fr), "+v"(fq));
        const int row0 = u.pm * BM + wr * 64 + fr, lane = fq * 16 + fr;
        unsigned char* const ws = kp->ws;
        bf16* const DQ = (bf16*)(ws + WS_DQ); bf16* const DK = (bf16*)(ws + WS_DK); bf16* const DV = (bf16*)(ws + WS_DV); bf16* const CQ = (bf16*)(ws + WS_CQ);
        bf16* const CKV = (bf16*)(ws + WS_CKV); bf16* const KR = (bf16*)(ws + WS_KR); bf16* const G = (bf16*)(ws + WS_G); bf16* const QM = (bf16*)(ws + WS_QM); bf16* const KV = (bf16*)(ws + WS_KV);
        bf16* const Y = (bf16*)(ws + WS_Y); bf16* const H = (bf16*)(ws + WS_H);
        float* const SSQ = (float*)(ws + WS_SSQ); const float* const TD = (const float*)(ws + WS_TD); const float* const TM = (const float*)(ws + WS_TM);
        if (mode == 0) {
#pragma unroll
            for (int bj = 0; bj < 2; ++bj) {
                const int c32 = u.pn * BM + bj * HALF + wc * 32, c0 = c32 + 8 * fq;
                if (c32 < 1024) {
                    bf16* dst = (c32 < 512) ? DQ : DK; const float sc = (c32 < 512) ? C2D : 1.f; const int cc = c0 & 511; const bool rope = (c32 & 32) == 0;
#pragma unroll
                    for (int ai = 0; ai < 2; ++ai)
#pragma unroll
                        for (int m = 0; m < 4; ++m) { const int row = row0 + ai * HALF + m * 16; f32x4 v0 = acc[ai][bj][m][0], v1 = acc[ai][bj][m][1];
                            if (rope) { const f32x4 q0 = shx(v0, 16, lane), q1 = shx(v1, 16, lane);
                                if (fq < 2) { const float* t = TD + (size_t)row * 16; const float sg = fq == 0 ? -1.f : 1.f;
                                    const f32x4 cs0 = *(const f32x4*)(t), cs1 = *(const f32x4*)(t + 4), sn0 = *(const f32x4*)(t + 8), sn1 = *(const f32x4*)(t + 12);
                                    v0 = v0 * cs0 + (q0 * sn0) * sg; v1 = v1 * cs1 + (q1 * sn1) * sg; } }
                            st8_nt(dst + (size_t)row * 512 + cc, v0 * sc, v1 * sc); }
                } else if (c32 < 1536) {
#pragma unroll
                    for (int ai = 0; ai < 2; ++ai)
#pragma unroll
                        for (int m = 0; m < 4; ++m) { const int row = row0 + ai * HALF + m * 16; st8_nt(DV + (size_t)row * 512 + (c0 - 1024), acc[ai][bj][m][0], acc[ai][bj][m][1]); }
                } else if (c32 < 2176) {
                    const bool isq = c32 < 1920; bf16* dst = isq ? CQ : CKV; const int pitch = isq ? 384 : 256, cc = isq ? c0 - 1536 : c0 - 1920, slot = isq ? (c32 - 1536) / 32 : 12 + (c32 - 1920) / 32;
#pragma unroll
                    for (int ai = 0; ai < 2; ++ai)
#pragma unroll
                        for (int m = 0; m < 4; ++m) { const int row = row0 + ai * HALF + m * 16; const f32x4 v0 = acc[ai][bj][m][0], v1 = acc[ai][bj][m][1];
                            float s = (v0[0] * v0[0] + v0[1] * v0[1]) + (v0[2] * v0[2] + v0[3] * v0[3]) + (v1[0] * v1[0] + v1[1] * v1[1]) + (v1[2] * v1[2] + v1[3] * v1[3]);
                            s += px(s, 16, lane); s += px(s, 32, lane);
                            if (fq == 0) SSQ[(size_t)row * 20 + slot] = s;
                            st8_nt(dst + (size_t)row * pitch + cc, v0, v1); }
                } else if (c32 < 2208) {
#pragma unroll
                    for (int ai = 0; ai < 2; ++ai)
#pragma unroll
                        for (int m = 0; m < 4; ++m) { const int row = row0 + ai * HALF + m * 16; f32x4 v0 = acc[ai][bj][m][0], v1 = acc[ai][bj][m][1];
                            rope32(v0, v1, TM + (size_t)row * 32, fq, lane); st8(KR + (size_t)row * 32 + 8 * fq, v0, v1); }
                } else if (c32 < DIN) {
                    const float* const gate_b = kp->gate_b; const int gc = c0 - 2208; const f32x4 b0 = *(const f32x4*)(gate_b + gc), b1 = *(const f32x4*)(gate_b + gc + 4);
#pragma unroll
                    for (int ai = 0; ai < 2; ++ai)
#pragma unroll
                        for (int m = 0; m < 4; ++m) { const int row = row0 + ai * HALF + m * 16; f32x4 v0 = acc[ai][bj][m][0] + b0, v1 = acc[ai][bj][m][1] + b1;
#pragma unroll
                            for (int j = 0; j < 4; ++j) { v0[j] = __builtin_amdgcn_rcpf(1.f + __expf(-v0[j])); v1[j] = __builtin_amdgcn_rcpf(1.f + __expf(-v1[j])); }
                            st8_nt(G + (size_t)row * 2048 + gc, v0, v1); }
                }
            }
        } else if (mode == 1 || mode == 2) {
            float rs[2][4];
#pragma unroll
            for (int ai = 0; ai < 2; ++ai)
#pragma unroll
                for (int m = 0; m < 4; ++m) { const float* sp = SSQ + (size_t)(row0 + ai * HALF + m * 16) * 20;
                    if (mode == 1) { const f32x4 a = *(const f32x4*)(sp), b = *(const f32x4*)(sp + 4), c = *(const f32x4*)(sp + 8);
                        const float t = ((a[0] + a[1]) + (a[2] + a[3])) + ((b[0] + b[1]) + (b[2] + b[3])) + ((c[0] + c[1]) + (c[2] + c[3])); rs[ai][m] = 1.0f / sqrtf(t * (1.f / 384.f) + RMS_EPS); }
                    else { const f32x4 a = *(const f32x4*)(sp + 12), b = *(const f32x4*)(sp + 16);
                        const float t = ((a[0] + a[1]) + (a[2] + a[3])) + ((b[0] + b[1]) + (b[2] + b[3])); rs[ai][m] = 1.0f / sqrtf(t * (1.f / 256.f) + RMS_EPS); } }
#pragma unroll
            for (int bj = 0; bj < 2; ++bj) {
                const int c32 = u.pn * BM + bj * HALF + wc * 32, c0 = c32 + 8 * fq; const bool rope = (mode == 1) && ((c32 >> 5) % 3 == 2);
#pragma unroll
                for (int ai = 0; ai < 2; ++ai)
#pragma unroll
                    for (int m = 0; m < 4; ++m) { const int row = row0 + ai * HALF + m * 16; f32x4 v0 = acc[ai][bj][m][0] * rs[ai][m], v1 = acc[ai][bj][m][1] * rs[ai][m];
                        if (mode == 1) { if (rope) rope32(v0, v1, TM + (size_t)row * 32, fq, lane); st8_nt(QM + (size_t)row * 768 + c0, v0 * C2M, v1 * C2M); }
                        else st8(KV + (size_t)row * 1024 + c0, v0, v1); }
            }
        } else if (mode == 7) {
            bf16* const X1B = (bf16*)(ws + WS_X1B);
#pragma unroll
            for (int bj = 0; bj < 2; ++bj) { const int c0 = u.pn * BM + bj * HALF + wc * 32 + 8 * fq;
#pragma unroll
                for (int ai = 0; ai < 2; ++ai)
#pragma unroll
                    for (int m = 0; m < 4; ++m) { const int row = row0 + ai * HALF + m * 16; bf16* p = X1B + (size_t)row * 1024 + c0; f32x4 x0, x1;
                        ld8(p, x0, x1); st8(p, x0 * ALPHA + acc[ai][bj][m][0], x1 * ALPHA + acc[ai][bj][m][1]); } }
        } else {
            float* const out = kp->out; const float* const x = kp->x;
#pragma unroll
            for (int bj = 0; bj < 2; ++bj) {
                const int c0 = u.pn * BM + bj * HALF + wc * 32 + 8 * fq;
#pragma unroll
                for (int ai = 0; ai < 2; ++ai)
#pragma unroll
                    for (int m = 0; m < 4; ++m) { const int row = row0 + ai * HALF + m * 16; const f32x4 a0 = acc[ai][bj][m][0], a1 = acc[ai][bj][m][1];
                        float* o = out + (size_t)row * 1024 + c0;
                        if (mode == 3) { f32x4 g0, g1; ld8(G + (size_t)row * 2048 + 1024 + c0, g0, g1); st8(Y + (size_t)row * 1024 + c0, a0 * g0, a1 * g1); }
                        else if (mode == 5) { const float* xr = x + (size_t)row * 1024 + c0; st8((bf16*)(ws + WS_X1B) + (size_t)row * 1024 + c0, __builtin_nontemporal_load((const f32x4*)xr) * ALPHA + a0, __builtin_nontemporal_load((const f32x4*)(xr + 4)) * ALPHA + a1); }
                        else if (mode == 6) { f32x4 r0, r1;
#pragma unroll
                            for (int j = 0; j < 4; ++j) { const float t0 = fmaxf(a0[j], 0.f), t1 = fmaxf(a1[j], 0.f); r0[j] = t0 * t0; r1[j] = t1 * t1; }
                            st8_nt(H + (size_t)row * DFF + c0, r0, r1); }
                        else { } }
            }
        }
    }
};

namespace att {
typedef LAS const char* lds_cptr;
typedef float f32x2_t __attribute__((ext_vector_type(2))); typedef __bf16 bf16x2_t __attribute__((ext_vector_type(2)));
__device__ __forceinline__ int crow(int r, int hi) { return (r & 3) + 8 * (r >> 2) + 4 * hi; }
__device__ __forceinline__ unsigned cvtpk_s(float lo, float hi) { f32x2_t v = {lo, hi}; bf16x2_t b = __builtin_convertvector(v, bf16x2_t); return __builtin_bit_cast(unsigned, b); }
__device__ __forceinline__ void glds16(const void* gsrc, unsigned lds_dst) { unsigned keep;
    asm volatile("s_mov_b32 %0, m0\n\ts_mov_b32 m0, %2\n\ts_nop 0\n\tglobal_load_lds_dwordx4 %1, off\n\ts_mov_b32 m0, %0" : "=&s"(keep) : "v"(gsrc), "s"(lds_dst) : "memory"); }
constexpr int L_K = 0, KSLOT = 12288, L_V = 24576, VSLOT = 16384, L_WS = 57344;
struct Src { const bf16* Q; int qp; const bf16* K1; int k1p; const bf16* K2; int k2p; const bf16* V; int vp; };

typedef short v4i16_t __attribute__((ext_vector_type(4)));
__device__ __forceinline__ s16x4 vtr(lds_cptr p) { return __builtin_bit_cast(s16x4, __builtin_amdgcn_ds_read_tr16_b64_v4i16((LAS v4i16_t*)p)); }

template <int DQK>
__device__ __forceinline__ void qk_tile(lds_cptr kb, const bf16x8 (&qr)[DQK / 16], f32x16& p0, f32x16& p1) {
    p0 = f32x16{}; p1 = f32x16{};
#pragma unroll
    for (int d0 = 0; d0 < DQK / 16; ++d0) { const bf16x8 b0 = *(const LAS bf16x8*)(kb + d0 * 2048), b1 = *(const LAS bf16x8*)(kb + d0 * 2048 + 512);
        p0 = __builtin_amdgcn_mfma_f32_32x32x16_bf16(b0, qr[d0], p0, 0, 0, 0); p1 = __builtin_amdgcn_mfma_f32_32x32x16_bf16(b1, qr[d0], p1, 0, 0, 0); }
}

__device__ __forceinline__ float max_halves(float v) { const unsigned u = __builtin_bit_cast(unsigned, v); auto rr = __builtin_amdgcn_permlane32_swap(u, u, false, false);
    return fmaxf(__builtin_bit_cast(float, (unsigned)rr[0]), __builtin_bit_cast(float, (unsigned)rr[1])); }
#define ATT_FENCE() __builtin_amdgcn_sched_barrier(0)

template <int DQK, int DV, bool MASKN, int THR>
__device__ __forceinline__ void attn_step(lds_cptr kb_next, lds_cptr vb, const bf16x8 (&qr)[DQK / 16], f32x16& c0, f32x16& c1, f32x16& n0, f32x16& n1, float& rm,
                                          f32x16& negm, float& mhat, f32x16 (&o)[DV / 32], float& l_run, LAS float* wsf, int t, int qabs, int r32, int hi) {
    constexpr int ND = DQK / 16;
    if (__any(rm > (float)THR)) {
        const float dl = fmaxf(rm, 0.f); mhat += dl;
#pragma unroll
        for (int r = 0; r < 16; ++r) { c0[r] -= dl; c1[r] -= dl; negm[r] = -mhat; }
        const float f = __builtin_amdgcn_exp2f(-dl); l_run *= f;
        if (hi == 0) wsf[r32] = f;
#pragma unroll
        for (int k = 0; k < 4; ++k) { const f32x4 a = *(const LAS f32x4*)(wsf + 8 * k + 4 * hi);
#pragma unroll
            for (int d = 0; d < DV / 32; ++d) { o[d][4 * k] *= a[0]; o[d][4 * k + 1] *= a[1]; o[d][4 * k + 2] *= a[2]; o[d][4 * k + 3] *= a[3]; } }
    }
    bf16x8 b0 = *(const LAS bf16x8*)(kb_next), b1 = *(const LAS bf16x8*)(kb_next + 512);
    ATT_FENCE();
#pragma unroll
    for (int d0 = 0; d0 < ND; ++d0) {
        bf16x8 nb0 = b0, nb1 = b1;
        if (d0 + 1 < ND) { nb0 = *(const LAS bf16x8*)(kb_next + (d0 + 1) * 2048); nb1 = *(const LAS bf16x8*)(kb_next + (d0 + 1) * 2048 + 512); }
        if (d0 == 0) { n0 = __builtin_amdgcn_mfma_f32_32x32x16_bf16(b0, qr[0], negm, 0, 0, 0); n1 = __builtin_amdgcn_mfma_f32_32x32x16_bf16(b1, qr[0], negm, 0, 0, 0); }
        else { n0 = __builtin_amdgcn_mfma_f32_32x32x16_bf16(b0, qr[d0], n0, 0, 0, 0); n1 = __builtin_amdgcn_mfma_f32_32x32x16_bf16(b1, qr[d0], n1, 0, 0, 0); }
#pragma unroll
        for (int e = (8 * d0) / ND; e < (8 * (d0 + 1)) / ND; ++e) c0[e] = __builtin_amdgcn_exp2f(c0[e]);
        ATT_FENCE();
        b0 = nb0; b1 = nb1;
    }
    float sum = 0.f, rmn = -INFINITY;
    int thr = qabs - 64 * (t + 1) - 4 * hi; asm volatile("" : "+v"(thr));
    if constexpr (DV == 64) {
    constexpr int NSG = DV / 64;
#pragma unroll
    for (int ks = 0; ks < 4; ++ks) {
        f32x16& src = (ks < 2) ? c0 : c1; const int base = (ks & 1) * 8;
        const v4u pw = (v4u){cvtpk_s(src[base], src[base + 1]), cvtpk_s(src[base + 2], src[base + 3]), cvtpk_s(src[base + 4], src[base + 5]), cvtpk_s(src[base + 6], src[base + 7])};
#pragma unroll
        for (int sg = 0; sg < NSG; ++sg) {
            s16x4 lo[2], hh[2];
#pragma unroll
            for (int e = 0; e < 2; ++e) { lo[e] = vtr(vb + (2 * sg + e) * 4096 + ks * 1024); hh[e] = vtr(vb + (2 * sg + e) * 4096 + ks * 1024 + 512); }
            ATT_FENCE();
            if (sg == 0 && ks < 3) { f32x16& nsrc = (ks + 1 < 2) ? c0 : c1; const int nbase = ((ks + 1) & 1) * 8;
#pragma unroll
                for (int j = 0; j < 8; ++j) nsrc[nbase + j] = __builtin_amdgcn_exp2f(nsrc[nbase + j]); }
            if (sg == NSG - 1) {
#pragma unroll
                for (int j = 0; j < 8; ++j) sum += src[base + j];
                f32x16& nx = (ks < 2) ? n0 : n1;
#pragma unroll
                for (int j = 0; j < 8; ++j) { const int r = base + j;
                    if (MASKN) { if ((r & 3) + 8 * (r >> 2) + ((ks < 2) ? 0 : 32) > thr) nx[r] = -INFINITY; }
                    rmn = fmaxf(rmn, nx[r]); } }
            ATT_FENCE();
#pragma unroll
            for (int e = 0; e < 2; ++e) { const bf16x8 vf = (bf16x8){lo[e][0], lo[e][1], lo[e][2], lo[e][3], hh[e][0], hh[e][1], hh[e][2], hh[e][3]};
                o[2 * sg + e] = __builtin_amdgcn_mfma_f32_32x32x16_bf16(__builtin_bit_cast(bf16x8, pw), vf, o[2 * sg + e], 0, 0, 0); }
            ATT_FENCE();
        }
    }
    } else {
#pragma unroll
    for (int ks = 0; ks < 4; ++ks) {
        f32x16& src = (ks < 2) ? c0 : c1; const int base = (ks & 1) * 8;
        const v4u pw = (v4u){cvtpk_s(src[base], src[base + 1]), cvtpk_s(src[base + 2], src[base + 3]), cvtpk_s(src[base + 4], src[base + 5]), cvtpk_s(src[base + 6], src[base + 7])};
#pragma unroll
        for (int d0 = 0; d0 < DV / 32; ++d0) { const s16x4 lo = vtr(vb + d0 * 4096 + ks * 1024), hh = vtr(vb + d0 * 4096 + ks * 1024 + 512);
            const bf16x8 vf = (bf16x8){lo[0], lo[1], lo[2], lo[3], hh[0], hh[1], hh[2], hh[3]};
            o[d0] = __builtin_amdgcn_mfma_f32_32x32x16_bf16(__builtin_bit_cast(bf16x8, pw), vf, o[d0], 0, 0, 0); }
        if (ks < 3) { f32x16& nsrc = (ks + 1 < 2) ? c0 : c1; const int nbase = ((ks + 1) & 1) * 8;
#pragma unroll
            for (int j = 0; j < 8; ++j) nsrc[nbase + j] = __builtin_amdgcn_exp2f(nsrc[nbase + j]); }
#pragma unroll
        for (int j = 0; j < 8; ++j) sum += src[base + j];
        { f32x16& nx = (ks < 2) ? n0 : n1;
#pragma unroll
          for (int j = 0; j < 8; ++j) { const int r = base + j;
              if (MASKN) { if ((r & 3) + 8 * (r >> 2) + ((ks < 2) ? 0 : 32) > thr) nx[r] = -INFINITY; }
              rmn = fmaxf(rmn, nx[r]); } }
        ATT_FENCE();
    }
    }
    l_run += sum;
    rm = max_halves(rmn);
}

template <int DQK, int DV, int NK1>
__device__ __forceinline__ void attn_core(const Src& s, int q0, char* shm, f32x16 (&o)[DV / 32], const int tid_in) {
    constexpr int THR = 8;
    const int tid = tid_in, lane = tid & 63, r32 = lane & 31, hi = lane >> 5; const int wid = __builtin_amdgcn_readfirstlane(tid >> 6);
    const unsigned lds0 = (unsigned)(uintptr_t)shm;
    LAS float* wsf = (LAS float*)((LAS char*)shm + L_WS) + wid * 64;
    constexpr int NKC = DQK / 8, NVP = DV / 8;
#define ATT_DMA_K(t, slot) do { \
        _Pragma("unroll") for (int c_ = 0; c_ < (NKC + 7) / 8; ++c_) { const int ch = wid + 8 * c_; if (ch < NKC) { \
            const bf16* src_ = (ch < NK1) ? s.K1 + (size_t)(64 * (t) + lane) * s.k1p + ch * 8 : s.K2 + (size_t)(64 * (t) + lane) * s.k2p + (ch - NK1) * 8; \
            glds16(src_, (unsigned)__builtin_amdgcn_readfirstlane(lds0 + L_K + (slot) * KSLOT + ch * 1024)); } } } while (0)
#define ATT_DMA_V(t, slot) do { \
        _Pragma("unroll") for (int c_ = 0; c_ < NVP / 8; ++c_) { const int p_ = wid + 8 * c_; const int db = p_ >> 2, rg = p_ & 3; \
            const bf16* src_ = s.V + (size_t)(64 * (t) + 16 * rg + (lane >> 2)) * s.vp + 32 * db + (lane & 3) * 8; \
            glds16(src_, (unsigned)__builtin_amdgcn_readfirstlane(lds0 + L_V + (slot) * VSLOT + p_ * 1024)); } } while (0)
#define ATT_BAR() asm volatile("s_waitcnt vmcnt(0) lgkmcnt(0)\n\ts_barrier" ::: "memory")
    ATT_DMA_K(0, 0); ATT_DMA_V(0, 0); ATT_DMA_K(1, 1);
    bf16x8 qr[DQK / 16];
#pragma unroll
    for (int d0 = 0; d0 < DQK / 16; ++d0) qr[d0] = *(const bf16x8*)(s.Q + (size_t)(q0 + wid * 32 + r32) * s.qp + d0 * 16 + hi * 8);
    float l_run = 0.f;
#pragma unroll
    for (int d = 0; d < DV / 32; ++d) o[d] = f32x16{};
    const int NT = (q0 + 256) / 64; const int qw0 = q0 + wid * 32, qabs = qw0 + r32;
    const int tlast = (qw0 + 31) >> 6;
    const lds_cptr kb0 = (lds_cptr)((LAS char*)shm) + L_K + hi * 1024 + r32 * 16;
    const lds_cptr vb0 = (lds_cptr)((LAS char*)shm) + L_V + ((lane >> 4) & 1) * 32 + (lane & 3) * 8 + (4 * hi + ((lane & 15) >> 2)) * 64;
    ATT_BAR();
    f32x16 a0, a1, b0_, b1_, negm; float rm, mhat;
    qk_tile<DQK>(kb0, qr, a0, a1);
    if (NT == 4) {
#pragma unroll
        for (int r = 0; r < 16; ++r) { const int thr0 = qabs - 4 * hi; if ((r & 3) + 8 * (r >> 2) > thr0) a0[r] = -INFINITY; if ((r & 3) + 8 * (r >> 2) + 32 > thr0) a1[r] = -INFINITY; }
    }
    { float v = fmaxf(a0[0], a1[0]);
#pragma unroll
      for (int r = 1; r < 16; ++r) v = fmaxf(v, fmaxf(a0[r], a1[r]));
      mhat = max_halves(v); rm = 0.f;
#pragma unroll
      for (int r = 0; r < 16; ++r) { a0[r] -= mhat; a1[r] -= mhat; negm[r] = -mhat; } }
    int t = 0;
    for (; t < NT - 6; t += 2) {
        ATT_BAR(); ATT_DMA_K(t + 2, 0); ATT_DMA_V(t + 1, 1);
        attn_step<DQK, DV, false, THR>(kb0 + KSLOT, vb0, qr, a0, a1, b0_, b1_, rm, negm, mhat, o, l_run, wsf, t, qabs, r32, hi);
        ATT_BAR(); ATT_DMA_K(t + 3, 1); ATT_DMA_V(t + 2, 0);
        attn_step<DQK, DV, false, THR>(kb0, vb0 + VSLOT, qr, b0_, b1_, a0, a1, rm, negm, mhat, o, l_run, wsf, t + 1, qabs, r32, hi);
    }
    for (; t < NT; t += 2) {
        ATT_BAR(); if (t + 2 < NT) ATT_DMA_K(t + 2, 0); ATT_DMA_V(t + 1, 1);
        if (t <= tlast) attn_step<DQK, DV, true, THR>(kb0 + KSLOT, vb0, qr, a0, a1, b0_, b1_, rm, negm, mhat, o, l_run, wsf, t, qabs, r32, hi);
        ATT_BAR(); if (t + 3 < NT) ATT_DMA_K(t + 3, 1); if (t + 2 < NT) ATT_DMA_V(t + 2, 0);
        if (t + 1 <= tlast) attn_step<DQK, DV, true, THR>(kb0, vb0 + VSLOT, qr, b0_, b1_, a0, a1, rm, negm, mhat, o, l_run, wsf, t + 1, qabs, r32, hi);
    }
#undef ATT_DMA_K
#undef ATT_DMA_V
#undef ATT_BAR
    l_run += shxl(l_run, 32, lane);
    if (hi == 0) wsf[32 + r32] = 1.0f / l_run;
#pragma unroll
    for (int k = 0; k < 4; ++k) { const f32x4 a = *(const LAS f32x4*)(wsf + 32 + 8 * k + 4 * hi);
#pragma unroll
        for (int d = 0; d < DV / 32; ++d) { o[d][4 * k] *= a[0]; o[d][4 * k + 1] *= a[1]; o[d][4 * k + 2] *= a[2]; o[d][4 * k + 3] *= a[3]; } }
}
}

#define RLX_AGENT __ATOMIC_RELAXED, __HIP_MEMORY_SCOPE_AGENT
#define XB_TMO      128
#define XB_XCNT(j)  (256  + 64 * (j))
#define XB_XSUB(j)  (1280 + 64 * (j))
#define XB_XGEN(j)  (2304 + 64 * (j))
#define XB_TOP      3328
#define XB_TOPGEN   3392
#define XCD_BAR_WORDS 3456
#define XB_SPIN_CAP (1u << 18)

__device__ __forceinline__ unsigned xb_ld(unsigned* p)              { return __hip_atomic_load(p, __ATOMIC_RELAXED, __HIP_MEMORY_SCOPE_AGENT); }
__device__ __forceinline__ unsigned xb_add(unsigned* p, unsigned v) { return __hip_atomic_fetch_add(p, v, __ATOMIC_RELAXED, __HIP_MEMORY_SCOPE_AGENT); }
__device__ __forceinline__ unsigned xb_xcc_id() { return (unsigned)__builtin_amdgcn_s_getreg((3 << 11) | 20) & 0xFu; }
#define XB_SPIN(cond, bar) do { unsigned _sp = 0; while (cond) { __builtin_amdgcn_s_sleep(1); \
    if ((++_sp & 255u) == 0u) { if (xb_ld(&(bar)[XB_TMO])) break; if (_sp > XB_SPIN_CAP) { atomicAdd(&(bar)[XB_TMO], 1u); break; } } } } while (0)

struct XcdBarrier {
    unsigned* bar; unsigned x;
    volatile LAS unsigned* st;
};

__device__ __forceinline__ XcdBarrier xcd_barrier_post(unsigned* bar, volatile LAS unsigned* st) {
    XcdBarrier b; b.bar = bar; b.x = xb_xcc_id(); b.st = st;
    if (threadIdx.x == 0) (void)xb_add(&bar[XB_XCNT(b.x)], 1u);
    return b;
}
__device__ __forceinline__ void xcd_barrier_complete(unsigned* bar, unsigned x, unsigned& nloc, unsigned& nx) {
    const unsigned G = gridDim.x * gridDim.y * gridDim.z;
    unsigned sum, cnt, mine, sp = 0u;
    for (;;) {
        sum = 0u; cnt = 0u; mine = 0u;
#pragma unroll
        for (unsigned j = 0; j < 16; ++j) { const unsigned c = xb_ld(&bar[XB_XCNT(j)]); sum += c; cnt += (c > 0u) ? 1u : 0u; mine = (j == x) ? c : mine; }
        if (sum == G) break;
        __builtin_amdgcn_s_sleep(1);
        if ((++sp & 255u) == 0u) { if (xb_ld(&bar[XB_TMO])) break; if (sp > XB_SPIN_CAP) { atomicAdd(&bar[XB_TMO], 1u); break; } }
    }
    nloc = mine > 0u ? mine : 1u; nx = cnt > 0u ? cnt : 1u;
}

__device__ __forceinline__ void xcd_barrier(const XcdBarrier b) {
    asm volatile("s_waitcnt vmcnt(0)" ::: "memory");
    __syncthreads();
    if (threadIdx.x == 0) {
        unsigned* bar = b.bar;
        __builtin_amdgcn_s_waitcnt(0);
        unsigned nloc = b.st[0], nx = b.st[1];
        if (nloc == 0u) { xcd_barrier_complete(bar, b.x, nloc, nx); b.st[0] = nloc; b.st[1] = nx; }
        const unsigned old = xb_add(&bar[XB_XSUB(b.x)], 1u);
        const unsigned gen = old / nloc;
        if (old + 1u == (gen + 1u) * nloc) {
            __builtin_amdgcn_fence(__ATOMIC_RELEASE, "agent");
            asm volatile("s_waitcnt vmcnt(0)" ::: "memory");
            const unsigned og = xb_add(&bar[XB_TOP], 1u);
            const unsigned tg = og / nx;
            if (og + 1u == (tg + 1u) * nx) xb_add(&bar[XB_TOPGEN], 1u);
            else XB_SPIN(xb_ld(&bar[XB_TOPGEN]) == tg, bar);
            __builtin_amdgcn_fence(__ATOMIC_ACQUIRE, "agent");
            xb_add(&bar[XB_XGEN(b.x)], 1u);
            asm volatile("s_waitcnt vmcnt(0)" ::: "memory");
        } else {
            XB_SPIN(xb_ld(&bar[XB_XGEN(b.x)]) == gen, bar);
            __builtin_amdgcn_fence(__ATOMIC_ACQUIRE, "agent");
            asm volatile("s_waitcnt vmcnt(0)" ::: "memory");
        }
    }
    __syncthreads();
}

__device__ __forceinline__ void p0_transpose_item(const float* W, const float* gain, int K, int N, bf16* WT, LAS float* scr, int item, int lane, int ldk = 0, int koff = 0) {
    if (ldk == 0) ldk = K;
    const int nblk = N / 32, kb = item / nblk, nb = item % nblk, k0 = 64 * kb, n0 = 32 * nb;
#pragma unroll 8
    for (int i = 0; i < 32; ++i) { const int kk = 2 * i + (lane >> 5); float v = __builtin_nontemporal_load(W + (size_t)(k0 + kk) * N + n0 + (lane & 31)); if (gain) v *= gain[k0 + kk]; scr[kk * 33 + (lane & 31)] = v; }
    asm volatile("s_waitcnt lgkmcnt(0)" ::: "memory");
    const int c = lane & 7;
#pragma unroll
    for (int j = 0; j < 4; ++j) { const int n = (lane >> 3) + 8 * j; const LAS float* sp = scr + (8 * c) * 33 + n;
        v4u o; o.x = pk2(sp[0 * 33], sp[1 * 33]); o.y = pk2(sp[2 * 33], sp[3 * 33]); o.z = pk2(sp[4 * 33], sp[5 * 33]); o.w = pk2(sp[6 * 33], sp[7 * 33]);
        *(v4u*)(WT + (size_t)(n0 + n) * ldk + koff + k0 + 8 * c) = o; }
    asm volatile("s_waitcnt lgkmcnt(0)" ::: "memory");
}
__device__ __forceinline__ void sincos_red(float ang, float& c, float& sn) {
    const double rev = (double)ang * 0.15915494309189535; const float fr = (float)(rev - __builtin_rint(rev));
    c = __builtin_amdgcn_cosf(fr); sn = __builtin_amdgcn_sinf(fr);
}
template <int NR>
__device__ __forceinline__ void ln_rows_b(const bf16* src, bf16* d16, float* d32, size_t m0, size_t rstride, const float* g, const float* b, int lane) {
    v4u raw[NR][2]; f32x4 v[NR][4]; float mean[NR], rstd[NR];
#pragma unroll
    for (int i = 0; i < NR; ++i) { const bf16* r = src + (m0 + i * rstride) * 1024 + 8 * lane; if (d32) { raw[i][0] = __builtin_nontemporal_load((const v4u*)r); raw[i][1] = __builtin_nontemporal_load((const v4u*)(r + 512)); } else { raw[i][0] = *(const v4u*)r; raw[i][1] = *(const v4u*)(r + 512); } }
#pragma unroll
    for (int i = 0; i < NR; ++i) {
#pragma unroll
        for (int h = 0; h < 2; ++h) { const v4u w = raw[i][h];
            v[i][2 * h] = (f32x4){__builtin_bit_cast(float, w.x << 16), __builtin_bit_cast(float, w.x & 0xffff0000u), __builtin_bit_cast(float, w.y << 16), __builtin_bit_cast(float, w.y & 0xffff0000u)};
            v[i][2 * h + 1] = (f32x4){__builtin_bit_cast(float, w.z << 16), __builtin_bit_cast(float, w.z & 0xffff0000u), __builtin_bit_cast(float, w.w << 16), __builtin_bit_cast(float, w.w & 0xffff0000u)}; }
        float s = 0.f;
#pragma unroll
        for (int j = 0; j < 4; ++j) s += (v[i][j].x + v[i][j].y) + (v[i][j].z + v[i][j].w);
        mean[i] = wave_sum(s, lane) * (1.f / 1024.f); float s2 = 0.f;
#pragma unroll
        for (int j = 0; j < 4; ++j) { v[i][j] = v[i][j] - mean[i]; s2 += (v[i][j].x * v[i][j].x + v[i][j].y * v[i][j].y) + (v[i][j].z * v[i][j].z + v[i][j].w * v[i][j].w); }
        rstd[i] = 1.f / sqrtf(wave_sum(s2, lane) * (1.f / 1024.f) + LN_EPS); }
#pragma unroll
    for (int h = 0; h < 2; ++h) { const int c = 512 * h + 8 * lane;
        const f32x4 g0 = *(const f32x4*)(g + c), g1 = *(const f32x4*)(g + c + 4), b0 = *(const f32x4*)(b + c), b1 = *(const f32x4*)(b + c + 4);
#pragma unroll
        for (int i = 0; i < NR; ++i) { const f32x4 r0 = v[i][2 * h] * rstd[i] * g0 + b0, r1 = v[i][2 * h + 1] * rstd[i] * g1 + b1; const size_t off = (m0 + i * rstride) * 1024 + c;
            if (d16) *(v4u*)(d16 + off) = (v4u){pk2(r0.x, r0.y), pk2(r0.z, r0.w), pk2(r1.x, r1.y), pk2(r1.z, r1.w)};
            if (d32) { __builtin_nontemporal_store(r0, (f32x4*)(d32 + off)); __builtin_nontemporal_store(r1, (f32x4*)(d32 + off + 4)); } } }
}

__global__ void __launch_bounds__(NWAVES * 64, 2) mega_fwd(Params P_) {
    extern __shared__ __attribute__((aligned(16))) unsigned char lds[];
    cg::grid_group grid = cg::this_grid();
    const __attribute__((address_space(4))) Params* kp = (const __attribute__((address_space(4))) Params*)__builtin_amdgcn_kernarg_segment_ptr();
    asm volatile("" : "+s"(kp));
#define P (*kp)
    const int s_lo = P.s_lo, s_hi = P.s_hi;
    volatile LAS unsigned* const xb_st = (volatile LAS unsigned*)((LAS unsigned char*)lds + RING_BYTES + 64);
    if (s_hi - s_lo > 1) { if (threadIdx.x == 0) { xb_st[0] = 0u; xb_st[1] = 0u; } __syncthreads(); (void)xcd_barrier_post((unsigned*)(P.ws + WS_CTL), xb_st); }
    const int wave0 = __builtin_amdgcn_readfirstlane((int)threadIdx.x >> 6);
    for (int s = s_lo; s < s_hi; ++s) {
        int wv_ = wave0, bx_ = blockIdx.x, G_ = gridDim.x; asm volatile("" : "+s"(wv_), "+s"(bx_), "+s"(G_));
        const int wave = wv_;
#define LANE_ID() ({ int l_; asm volatile("v_mbcnt_lo_u32_b32 %0, -1, 0\n\tv_mbcnt_hi_u32_b32 %0, -1, %0" : "=v"(l_)); l_; })
        const int G = G_, bx = bx_, vcu = (G % 8 == 0) ? (bx % 8) * (G / 8) + bx / 8 : bx;
        unsigned char* const ws = P.ws;
        const int gw = vcu * NWAVES + wave, NGW = G * NWAVES;
        if (s == 0) {
            const int lane = LANE_ID(), tid = wave * 64 + lane;
            LAS float* scr = (LAS float*)((LAS unsigned char*)lds + wave * 16384);
            constexpr int I_IN = (1024 / 64) * (DIN / 32), I_UQ = (384 / 64) * (768 / 32), I_UKV = (256 / 64) * (1024 / 32), I_OD = (512 / 64) * (1024 / 32), I_OUT = (1024 / 64) * (1024 / 32),
                          I_UP = (1024 / 64) * (DFF / 32), I_DN = (DFF / 64) * (1024 / 32);
            constexpr int NITEMS = I_IN + I_UQ + I_UKV + 2 * I_OD + I_OUT + I_UP + I_DN;
            for (int it = gw; it < NITEMS; it += NGW) {
                int r = it;
                if (r < I_IN) { p0_transpose_item(P.w_in, nullptr, 1024, DIN, (bf16*)(ws + WS_WIN), scr, r, lane); continue; } r -= I_IN;
                if (r < I_UQ) { p0_transpose_item(P.w_uq, P.qn_g, 384, 768, (bf16*)(ws + WS_WUQ), scr, r, lane); continue; } r -= I_UQ;
                if (r < I_UKV) { p0_transpose_item(P.w_ukv, P.kvn_g, 256, 1024, (bf16*)(ws + WS_WUKV), scr, r, lane); continue; } r -= I_UKV;
                if (r < I_OD) { p0_transpose_item(P.w_od, nullptr, 512, 1024, (bf16*)(ws + WS_WOD), scr, r, lane, 1024, 0); continue; } r -= I_OD;
                if (r < I_OD) { p0_transpose_item(P.w_om, nullptr, 512, 1024, (bf16*)(ws + WS_WOD), scr, r, lane, 1024, 512); continue; } r -= I_OD;
                if (r < I_OUT) { p0_transpose_item(P.w_out, nullptr, 1024, 1024, (bf16*)(ws + WS_WOUT), scr, r, lane); continue; } r -= I_OUT;
                if (r < I_UP) { p0_transpose_item(P.w_up, nullptr, 1024, DFF, (bf16*)(ws + WS_WUP), scr, r, lane); continue; } r -= I_UP;
                p0_transpose_item(P.w_dn, nullptr, DFF, 1024, (bf16*)(ws + WS_WDN), scr, r, lane);
            }
            const int gt = vcu * (NWAVES * 64) + tid, NGT = G * NWAVES * 64;
            { v4u* z = (v4u*)(ws + WS_WIN + (size_t)DIN * 1024 * 2);
              for (int i = gt; i < (DINP - DIN) * 1024 * 2 / 16; i += NGT) { unsigned z_ = 0u; asm volatile("" : "+v"(z_)); z[i] = (v4u){z_, z_, z_, z_}; } }
            { const f32x4* xs = (const f32x4*)P.x; v4u* xd = (v4u*)(ws + WS_XB);
              for (int i = gt; i < NTOK * 1024 / 8; i += NGT) { const f32x4 a = __builtin_nontemporal_load(xs + 2 * i), b = __builtin_nontemporal_load(xs + 2 * i + 1); xd[i] = (v4u){pk2(a.x, a.y), pk2(a.z, a.w), pk2(b.x, b.y), pk2(b.z, b.w)}; } }
            { float* TD = (float*)(ws + WS_TD); float* TM = (float*)(ws + WS_TM);
              for (int i = gt; i < NTOK * 24; i += NGT) { const int tok = i / 24, j = i % 24; const float pf = (float)P.pos[tok];
                  if (j < 8) { const float inv = P.invf[j]; float c, sn; sincos_red(pf * inv, c, sn); TD[tok * 16 + j] = c; TD[tok * 16 + 8 + j] = sn; }
                  else { const int k = j - 8; const float inv = P.invf[j]; float c, sn; sincos_red(pf * inv, c, sn); TM[tok * 32 + k] = c; TM[tok * 32 + 16 + k] = sn; } } }
        } else if (s == 4) {
            const int lane = LANE_ID(), tid = wave * 64 + lane;
            char* shm = (char*)lds;
            const int r32 = lane & 31, hi = lane >> 5;
            float lamf;
            { const float* L = P.diff_lambda; const float a = wave_sum(L[lane] * L[64 + lane], lane), b = wave_sum(L[128 + lane] * L[192 + lane], lane); lamf = __expf(a) - __expf(b) + LAMBDA_INIT; }
            if (G == 256) {
                const int bh = vcu >> 2, sidx = vcu & 3, b = bh >> 2, h = bh & 3;
                const bf16* DQ = (const bf16*)(ws + WS_DQ) + (size_t)b * SEQ * 512 + h * 128; const bf16* DK = (const bf16*)(ws + WS_DK) + (size_t)b * SEQ * 512 + h * 128;
                const bf16* DV = (const bf16*)(ws + WS_DV) + (size_t)b * SEQ * 512 + h * 128; bf16* OD = (bf16*)(ws + WS_OD) + (size_t)b * SEQ * 1024 + h * 128;
                f32x4* scr1 = (f32x4*)(ws + WS_O1) + ((size_t)bx * 512 + tid) * 16;
                for (int i = 0; i < 4; ++i) {
                    const int qb = (i == 0) ? sidx : (i == 1) ? 7 - sidx : (i == 2) ? 8 + sidx : 15 - sidx; const int q0 = qb * 256;
                    for (int map = 0; map < 2; ++map) {
                        att::Src S{DQ + map * 64, 512, DK + map * 64, 512, DK, 512, DV, 512};
                        f32x16 o[4];
                        att::attn_core<64, 128, 8>(S, q0, shm, o, tid);
                        if (map == 0) {
#pragma unroll
                            for (int d = 0; d < 4; ++d)
#pragma unroll
                                for (int k = 0; k < 4; ++k) scr1[d * 4 + k] = (f32x4){o[d][4 * k], o[d][4 * k + 1], o[d][4 * k + 2], o[d][4 * k + 3]};
                        } else {
                            float ss[16];
#pragma unroll
                            for (int r = 0; r < 16; ++r) ss[r] = 0.f;
#pragma unroll
                            for (int d = 0; d < 4; ++d)
#pragma unroll
                                for (int k = 0; k < 4; ++k) { const f32x4 a = scr1[d * 4 + k];
#pragma unroll
                                    for (int j = 0; j < 4; ++j) { const float v = a[j] - lamf * o[d][4 * k + j]; o[d][4 * k + j] = v; ss[4 * k + j] += v * v; } }
#pragma unroll
                            for (int r = 0; r < 16; ++r) { float v = ss[r];
#pragma unroll
                                for (int mk = 1; mk < 32; mk <<= 1) v += shxl(v, mk, lane);
                                ss[r] = (1.0f / sqrtf(v * (1.f / 128.f) + RMS_EPS)) * (1.0f - LAMBDA_INIT); }
                            float gsub[4];
#pragma unroll
                            for (int d = 0; d < 4; ++d) gsub[d] = P.subln_g[32 * d + r32];
                            const int hi_e = LANE_ID() >> 5;
#pragma unroll
                            for (int r = 0; r < 16; ++r) { const int rr = att::crow(r, hi_e); bf16* op = OD + (size_t)(q0 + wave * 32 + rr) * 1024 + r32;
#pragma unroll
                                for (int d = 0; d < 4; ++d) op[32 * d] = (bf16)f2bf(o[d][r] * ss[r] * gsub[d]); }
                        }
                    }
                }
                {
                    const int bh2 = vcu >> 1, s2 = vcu & 1, b2 = bh2 >> 3, h2 = bh2 & 7;
                    const bf16* QM = (const bf16*)(ws + WS_QM) + (size_t)b2 * SEQ * 768 + h2 * 96; const bf16* KV = (const bf16*)(ws + WS_KV) + (size_t)b2 * SEQ * 1024 + h2 * 128;
                    const bf16* KR = (const bf16*)(ws + WS_KR) + (size_t)b2 * SEQ * 32; bf16* OM = (bf16*)(ws + WS_OD) + (size_t)b2 * SEQ * 1024 + 512 + h2 * 64;
                    for (int i = 0; i < 8; ++i) {
                        const int pr = i >> 1, qb = (i & 1) ? (4 * pr + 3 - s2) : (4 * pr + s2); const int q0 = qb * 256;
                        att::Src S{QM, 768, KV, 1024, KR, 32, KV + 64, 1024};
                        f32x16 o[2];
                        att::attn_core<96, 64, 8>(S, q0, shm, o, tid);
                        const int hi_e = LANE_ID() >> 5;
#pragma unroll
                        for (int r = 0; r < 16; ++r) { const int rr = att::crow(r, hi_e); bf16* op = OM + (size_t)(q0 + wave * 32 + rr) * 1024 + r32;
                            op[0] = (bf16)f2bf(o[0][r]); op[32] = (bf16)f2bf(o[1][r]); }
                    }
                }
            }
        } else if (s == 8 || s == 11) {
            const int lane = LANE_ID();
            bf16* const XB1 = (bf16*)(ws + WS_X1B);
            if (s == 8) { for (int m = gw; m < NTOK / 4; m += NGW) ln_rows_b<4>(XB1, XB1, nullptr, (size_t)m, (size_t)(NTOK / 4), P.ln1_g, P.ln1_b, lane); }
            else { for (int m = gw; m < NTOK / 4; m += NGW) ln_rows_b<4>(XB1, nullptr, P.out, (size_t)m, (size_t)(NTOK / 4), P.ln2_g, P.ln2_b, lane); }
        } else if (s == 6) {
        } else {
            const int tid = wave * 64 + LANE_ID();
            int mode; const bf16* A; const bf16* Bt; int N, K;
            switch (s) {
                case 1: mode = 0; A = (const bf16*)(ws + WS_XB); Bt = (const bf16*)(ws + WS_WIN); N = DINP; K = 1024; break;
                case 2: mode = 1; A = (const bf16*)(ws + WS_CQ); Bt = (const bf16*)(ws + WS_WUQ); N = 768; K = 384; break;
                case 3: mode = 2; A = (const bf16*)(ws + WS_CKV); Bt = (const bf16*)(ws + WS_WUKV); N = 1024; K = 256; break;
                case 5: mode = 3; A = (const bf16*)(ws + WS_OD); Bt = (const bf16*)(ws + WS_WOD); N = 1024; K = 1024; break;
                case 7: mode = 5; A = (const bf16*)(ws + WS_Y); Bt = (const bf16*)(ws + WS_WOUT); N = 1024; K = 1024; break;
                case 9: mode = 6; A = (const bf16*)(ws + WS_X1B); Bt = (const bf16*)(ws + WS_WUP); N = DFF; K = 1024; break;
                default: mode = 7; A = (const bf16*)(ws + WS_H); Bt = (const bf16*)(ws + WS_WDN); N = 1024; K = DFF; break;
            }
            pg8::Gemm g{A, Bt, NTOK, N, K}; pg8::StaticOrder S; S.init(NTOK, N, G, bx);
            Epi E{mode, kp};
            pg8::gemm_phase<Epi, pg8::StaticOrder, true, true>((PG8_LAS unsigned char*)lds, g, S, E, tid);
        }
        if (s + 1 < s_hi) {
            const bool nosync = (s == 2 || s == 6);
            if (nosync) __syncthreads();
            else if (s_hi > 12) grid.sync();
            else { XcdBarrier xb; xb.bar = (unsigned*)(P.ws + WS_CTL); xb.x = xb_xcc_id(); xb.st = xb_st; xcd_barrier(xb); }
        }
    }
#undef P
#undef LANE_ID
}

#ifndef N_SPLIT
#define N_SPLIT 0
#endif
extern "C" void kernel_launch(void* const* d_in, const int* in_sizes, int n_in, void* d_out, int out_size, void* d_ws, size_t ws_size, hipStream_t stream) {
    static int grid = 0;
    if (grid == 0) {
        if (n_in != 19 || in_sizes[0] != NTOK * 1024 || out_size != NTOK * 1024 || ws_size < WS_END) { fprintf(stderr, "kernel_launch: unexpected shapes (n_in %d, ws %zu)\n", n_in, ws_size); grid = -1; return; }
        int dev = 0, cus = 0, per_cu = 0;
        hipGetDevice(&dev); hipDeviceGetAttribute(&cus, hipDeviceAttributeMultiprocessorCount, dev);
        if (hipFuncSetAttribute((const void*)mega_fwd, hipFuncAttributeMaxDynamicSharedMemorySize, LDS_BYTES) != hipSuccess) { fprintf(stderr, "kernel_launch: hipFuncSetAttribute failed\n"); grid = -1; return; }
        hipOccupancyMaxActiveBlocksPerMultiprocessor(&per_cu, (const void*)mega_fwd, NWAVES * 64, LDS_BYTES);
        (void)hipGetLastError();
        if (per_cu < 1 || cus < 256) fprintf(stderr, "kernel_launch: note: occupancy %d per CU, %d CUs\n", per_cu, cus);
        grid = 256;
    }
    if (grid < 0) return;
    Params p{};
    p.x = (const float*)d_in[0]; p.pos = (const int*)d_in[1]; p.w_in = (const float*)d_in[2]; p.gate_b = (const float*)d_in[3]; p.diff_lambda = (const float*)d_in[4]; p.subln_g = (const float*)d_in[5];
    p.qn_g = (const float*)d_in[6]; p.w_uq = (const float*)d_in[7]; p.kvn_g = (const float*)d_in[8]; p.w_ukv = (const float*)d_in[9]; p.w_od = (const float*)d_in[10]; p.w_om = (const float*)d_in[11];
    p.w_out = (const float*)d_in[12]; p.ln1_g = (const float*)d_in[13]; p.ln1_b = (const float*)d_in[14]; p.w_up = (const float*)d_in[15]; p.w_dn = (const float*)d_in[16]; p.ln2_g = (const float*)d_in[17]; p.ln2_b = (const float*)d_in[18];
    p.out = (float*)d_out; p.ws = (unsigned char*)d_ws;
    for (int j = 0; j < 8; ++j) p.invf[j] = (float)pow(500000.0, -(double)j / 8.0);
    for (int j = 0; j < 16; ++j) p.invf[8 + j] = (float)pow(500000.0, -(double)j / 16.0);
#if N_SPLIT
    const int cuts[11] = {0, 1, 2, 4, 5, 7, 8, 9, 10, 11, 12};
    for (int i = 0; i < 10; ++i) { p.s_lo = cuts[i]; p.s_hi = cuts[i + 1];
        hipLaunchKernelGGL(mega_fwd, dim3(grid), dim3(NWAVES * 64), LDS_BYTES, stream, p);
        const hipError_t le = hipPeekAtLastError(); if (le != hipSuccess) { fprintf(stderr, "kernel_launch: launch %d failed: %s\n", i, hipGetErrorName(le)); break; } }
#else
    p.s_lo = 0; p.s_hi = 12;
    if (hipMemsetAsync((char*)d_ws + WS_CTL, 0, CTL_BYTES, stream) != hipSuccess) { fprintf(stderr, "kernel_launch: hipMemsetAsync failed\n"); return; }
    void* args[] = {&p};
    const hipError_t e = hipLaunchCooperativeKernel((const void*)mega_fwd, dim3(grid), dim3(NWAVES * 64), args, LDS_BYTES, stream);
    if (e != hipSuccess) fprintf(stderr, "kernel_launch: cooperative launch failed: %s (grid %d)\n", hipGetErrorString(e), grid);
#endif
}
```

```cpp
#include <hip/hip_runtime.h>
#include <hip/hip_cooperative_groups.h>
#include <hip/hip_bf16.h>
#include <cstdio>
#include <cstdint>
#include <cmath>
namespace cg = cooperative_groups;
namespace pg8 {
#define PG8_LAS __attribute__((address_space(3)))
typedef unsigned short bf16_t;
typedef short bf16x8 __attribute__((ext_vector_type(8)));
typedef float f32x4 __attribute__((ext_vector_type(4)));
typedef unsigned u32x4 __attribute__((ext_vector_type(4)));
constexpr int BM = 256, BK = 64, HALF = 128, HTB = HALF * BK * 2  , STAGE_BYTES = 8 * HTB, NXCD = 8, WGM = 8;

__host__ __device__ __forceinline__ int lds_byte(int r, int c) { const int st = (r >> 4) * 2 + (c >> 5), rr = r & 15, cc = c & 31, ob = rr * 64 + cc * 2; return st * 1024 + (ob ^ (((ob >> 9) & 1) << 5)); }
__host__ __device__ __forceinline__ void stage_rc(int b, int& R, int& C) { const int st = b / 1024, sb = b % 1024, swz = sb ^ (((sb >> 9) & 1) << 5); R = (st >> 1) * 16 + swz / 64; C = (st & 1) * 32 + (swz % 64) / 2; }
__host__ __device__ __forceinline__ int perm32(int rho) { const int n = rho >> 4, i = rho & 15; return 8 * (i >> 2) + 4 * n + (i & 3); }

struct Unit { int pm, pn; };
struct Gemm { const bf16_t* A; const bf16_t* Bt; int M, N, K; };

struct StaticOrder {
    int nM, nN, nwg, G, c;
    __host__ __device__ void init(int M, int N, int G_, int c_) { nM = M / BM; nN = N / BM; nwg = nM * nN; G = G_; c = c_; }
    __host__ __device__ bool next(int i, Unit& u) const {
        const long L = (long)i * G + c; if (L >= nwg) return false;
        int wgid = (int)L; { const int q = nwg / NXCD, r = nwg % NXCD, xcd = wgid % NXCD, off = wgid / NXCD; wgid = (xcd < r ? xcd * (q + 1) : r * (q + 1) + (xcd - r) * q) + off; }
        const int nig = WGM * nN, gid = wgid / nig, fm = gid * WGM, gsz = (nM - fm) < WGM ? (nM - fm) : WGM;
        u.pm = fm + ((wgid % nig) % gsz); u.pn = (wgid % nig) / gsz; return true;
    }
    __device__ __forceinline__ void a_ready(const Unit&) const {}
    __device__ __forceinline__ void done(const Unit&) const {}
};

typedef float f32x2c __attribute__((ext_vector_type(2))); typedef __bf16 bf16x2c __attribute__((ext_vector_type(2)));
__device__ __forceinline__ unsigned cvt_pk_bf16(float lo, float hi) { f32x2c v = {lo, hi}; bf16x2c b = __builtin_convertvector(v, bf16x2c); return __builtin_bit_cast(unsigned, b); }
typedef float f32x2 __attribute__((ext_vector_type(2)));
template <class Epi, class Sched, bool ALIGN_EPI = false, bool SP2 = false>
__device__ __forceinline__ void gemm_phase(PG8_LAS unsigned char* lds, const Gemm g, const Sched& S, const Epi& E, const int tid_in) {
    const int tid = tid_in, wid = __builtin_amdgcn_readfirstlane(tid >> 6), lane = tid & 63, wr = wid >> 2, wc = wid & 3, fr = lane & 15, fq = lane >> 4;
    const int K = g.K, nt = K / BK;
    unsigned voffA[2], voffB[2];
#pragma unroll
    for (int i = 0; i < 2; ++i) { int R, C; stage_rc(tid * 16 + i * 8192, R, C); const int Rb = Epi::PERM ? ((R & ~31) + perm32(R & 31)) : R;
        voffA[i] = (unsigned)(R * K + C) * 2u; voffB[i] = (unsigned)(Rb * K + C) * 2u; }
    const size_t kstep = (size_t)(BK * 2);
    const size_t hstep = (size_t)HALF * K * 2;
    const size_t tstep = 2 * hstep;
    const unsigned ldsw = (unsigned)wid * 1024u;
    const int aoff = lds_byte(wr * 64 + fr, fq * 8), boff = lds_byte(wc * 32 + fr, fq * 8);
#define PG8_SA(b, h) (((b) * 2 + (h)) * HTB)
#define PG8_SB(b, h) ((4 + (b) * 2 + (h)) * HTB)
#define PG8_STAGE(bufoff, gbase, voff) do { _Pragma("unroll") for (int _i = 0; _i < 2; ++_i) \
        __builtin_amdgcn_global_load_lds((const unsigned*)((const char*)(gbase) + (voff)[_i]), (PG8_LAS unsigned*)(lds + (bufoff) + ldsw + _i * 8192), 16, 0, 0); } while (0)
#define PG8_LDA(dst, b, h) do { _Pragma("unroll") for (int m = 0; m < 4; ++m) _Pragma("unroll") for (int k = 0; k < 2; ++k) dst[m][k] = *(const PG8_LAS bf16x8*)(lds + PG8_SA(b, h) + aoff + m * 2048 + k * 1024); } while (0)
#define PG8_LDB(dst, b, h) do { _Pragma("unroll") for (int n = 0; n < 2; ++n) _Pragma("unroll") for (int k = 0; k < 2; ++k) dst[n][k] = *(const PG8_LAS bf16x8*)(lds + PG8_SB(b, h) + boff + n * 2048 + k * 1024); } while (0)
#define PG8_MMA(ai, bj, At, Bt) do { __builtin_amdgcn_s_setprio(1); _Pragma("unroll") for (int m = 0; m < 4; ++m) _Pragma("unroll") for (int n = 0; n < 2; ++n) _Pragma("unroll") for (int k = 0; k < 2; ++k) \
        acc[ai][bj][m][n] = __builtin_amdgcn_mfma_f32_16x16x32_bf16(Bt[n][k], At[m][k], acc[ai][bj][m][n], 0, 0, 0); __builtin_amdgcn_s_setprio(0); } while (0)
#define PG8_WAIT_V(n) asm volatile("s_waitcnt vmcnt(" #n ")" ::: "memory")
#define PG8_WAIT_L(n) asm volatile("s_waitcnt lgkmcnt(" #n ")" ::: "memory")
#define PG8_BAR __builtin_amdgcn_s_barrier()
#define PG8_SCHED __builtin_amdgcn_sched_barrier(0)
    Unit cur, nxt; int ui = 0;
    if (!S.next(0, cur)) return;
    f32x4 acc[2][2][4][2];
#pragma unroll
    for (int a = 0; a < 2; ++a)
#pragma unroll
        for (int b = 0; b < 2; ++b)
#pragma unroll
            for (int m = 0; m < 4; ++m)
#pragma unroll
                for (int n = 0; n < 2; ++n) { float z_ = 0.f; asm volatile("" : "+v"(z_)); acc[a][b][m][n] = (f32x4){z_, z_, z_, z_}; }
    E.init(acc, cur, wr, wc, fq);
    bf16x8 At[4][2], B0[2][2], B1[2][2];
    const char* cA = (const char*)g.A + (size_t)cur.pm * tstep; const char* cB = (const char*)g.Bt + (size_t)cur.pn * tstep;
    S.a_ready(cur);
    if constexpr (SP2) {
        PG8_STAGE(PG8_SB(0, 0), cB, voffB); PG8_STAGE(PG8_SB(0, 1), cB + hstep, voffB); PG8_STAGE(PG8_SA(0, 0), cA, voffA); PG8_STAGE(PG8_SA(0, 1), cA + hstep, voffA);
        if (wr == 1) PG8_BAR;
        PG8_WAIT_V(2); PG8_BAR;
        PG8_STAGE(PG8_SB(1, 0), cB + kstep, voffB); PG8_STAGE(PG8_SA(1, 0), cA + kstep, voffA); PG8_STAGE(PG8_SB(1, 1), cB + hstep + kstep, voffB);
        PG8_WAIT_V(6); PG8_BAR;
    } else {
        PG8_STAGE(PG8_SB(0, 0), cB, voffB); PG8_STAGE(PG8_SA(0, 0), cA, voffA); PG8_STAGE(PG8_SB(0, 1), cB + hstep, voffB); PG8_STAGE(PG8_SA(0, 1), cA + hstep, voffA);
        if (wr == 1) PG8_BAR;
        PG8_WAIT_V(4); PG8_BAR;
        PG8_STAGE(PG8_SB(1, 0), cB + kstep, voffB); PG8_STAGE(PG8_SA(1, 0), cA + kstep, voffA); PG8_STAGE(PG8_SB(1, 1), cB + hstep + kstep, voffB);
        PG8_WAIT_V(6); PG8_BAR;
    }
    for (;;) {
        const bool has_next = S.next(ui + 1, nxt);
        const char* nA = has_next ? (const char*)g.A + (size_t)nxt.pm * tstep : cA; const char* nB = has_next ? (const char*)g.Bt + (size_t)nxt.pn * tstep : cB;
        for (int t = 0; t < nt; t += 2) {
            if (E.mode == 3 && t == (nt >> 1)) E.mid(acc, cur, wr, wc, fr, fq);
            const bool last = (t == nt - 2);
            const char* a1 = cA + (size_t)(t + 1) * kstep;
            const char* a2 = last ? nA : cA + (size_t)(t + 2) * kstep; const char* b2 = last ? nB : cB + (size_t)(t + 2) * kstep;
            const char* a3 = a2 + kstep; const char* b3 = b2 + kstep;
            if (last && has_next) S.a_ready(nxt);
            if constexpr (SP2) {
            PG8_LDB(B0, 0, 0); PG8_LDB(B1, 0, 1); PG8_SCHED; PG8_LDA(At, 0, 0); PG8_STAGE(PG8_SA(1, 1), a1 + hstep, voffA);
            PG8_WAIT_V(8); PG8_WAIT_L(0); PG8_BAR; PG8_MMA(0, 0, At, B0); PG8_MMA(0, 1, At, B1); PG8_BAR; PG8_SCHED;
            PG8_LDA(At, 0, 1); PG8_STAGE(PG8_SB(0, 0), b2, voffB); PG8_STAGE(PG8_SB(0, 1), b2 + hstep, voffB); PG8_STAGE(PG8_SA(0, 0), a2, voffA);
            PG8_WAIT_V(8); PG8_WAIT_L(0); PG8_BAR; PG8_MMA(1, 0, At, B0); PG8_MMA(1, 1, At, B1); PG8_BAR; PG8_SCHED;
            PG8_LDB(B0, 1, 0); PG8_LDB(B1, 1, 1); PG8_SCHED; PG8_LDA(At, 1, 0); PG8_STAGE(PG8_SA(0, 1), a2 + hstep, voffA);
            PG8_WAIT_V(8); PG8_WAIT_L(0); PG8_BAR; PG8_MMA(0, 0, At, B0); PG8_MMA(0, 1, At, B1); PG8_BAR; PG8_SCHED;
            PG8_LDA(At, 1, 1); PG8_STAGE(PG8_SB(1, 0), b3, voffB); PG8_STAGE(PG8_SB(1, 1), b3 + hstep, voffB); PG8_STAGE(PG8_SA(1, 0), a3, voffA);
            PG8_WAIT_V(8); PG8_WAIT_L(0); PG8_BAR; PG8_MMA(1, 0, At, B0); PG8_MMA(1, 1, At, B1); PG8_BAR; PG8_SCHED;
            } else {
            PG8_LDB(B0, 0, 0); PG8_SCHED; PG8_LDA(At, 0, 0); PG8_STAGE(PG8_SA(1, 1), a1 + hstep, voffA);
            PG8_WAIT_L(8); PG8_BAR; PG8_WAIT_L(0); PG8_MMA(0, 0, At, B0); PG8_BAR; PG8_SCHED;
            PG8_LDB(B1, 0, 1); PG8_STAGE(PG8_SB(0, 0), b2, voffB);
            PG8_BAR; PG8_WAIT_L(0); PG8_MMA(0, 1, At, B1); PG8_BAR;
            PG8_LDA(At, 0, 1); PG8_STAGE(PG8_SA(0, 0), a2, voffA);
            PG8_BAR; PG8_WAIT_L(0); PG8_MMA(1, 0, At, B0); PG8_BAR; PG8_SCHED;
            PG8_STAGE(PG8_SB(0, 1), b2 + hstep, voffB);
            PG8_WAIT_V(6); PG8_BAR; PG8_MMA(1, 1, At, B1); PG8_BAR;
            PG8_LDB(B0, 1, 0); PG8_SCHED; PG8_LDA(At, 1, 0); PG8_STAGE(PG8_SA(0, 1), a2 + hstep, voffA);
            PG8_WAIT_L(8); PG8_BAR; PG8_WAIT_L(0); PG8_MMA(0, 0, At, B0); PG8_BAR; PG8_SCHED;
            PG8_LDB(B1, 1, 1); PG8_STAGE(PG8_SB(1, 0), b3, voffB);
            PG8_BAR; PG8_WAIT_L(0); PG8_MMA(0, 1, At, B1); PG8_BAR;
            PG8_LDA(At, 1, 1); PG8_STAGE(PG8_SA(1, 0), a3, voffA);
            PG8_BAR; PG8_WAIT_L(0); PG8_MMA(1, 0, At, B0); PG8_BAR; PG8_SCHED;
            PG8_STAGE(PG8_SB(1, 1), b3 + hstep, voffB);
            PG8_WAIT_V(6); PG8_BAR; PG8_MMA(1, 1, At, B1); PG8_BAR;
            }
        }
        if constexpr (ALIGN_EPI) { if (wr == 0) PG8_BAR; }
        if constexpr (!Epi::AFTER_DRAIN) { E(acc, cur, wr, wc, fr, fq); S.done(cur); }
        if (!has_next) break;
#pragma unroll
        for (int a = 0; a < 2; ++a)
#pragma unroll
            for (int b = 0; b < 2; ++b)
#pragma unroll
                for (int m = 0; m < 4; ++m)
#pragma unroll
                    for (int n = 0; n < 2; ++n) { float z_ = 0.f; asm volatile("" : "+v"(z_)); acc[a][b][m][n] = (f32x4){z_, z_, z_, z_}; }
        E.init(acc, nxt, wr, wc, fq);
        cur = nxt; cA = nA; cB = nB; ++ui;
        if constexpr (ALIGN_EPI) { if (wr == 1) PG8_BAR; }
    }
    PG8_WAIT_V(0);
    if constexpr (!ALIGN_EPI) { if (wr == 0) PG8_BAR; }
    PG8_BAR;
    if constexpr (Epi::AFTER_DRAIN) { E.fused(acc, cur, wr, wc, fr, fq, lds, wid, lane); S.done(cur); }
#undef PG8_SA
#undef PG8_SB
#undef PG8_STAGE
#undef PG8_LDA
#undef PG8_LDB
#undef PG8_MMA
#undef PG8_WAIT_V
#undef PG8_WAIT_L
#undef PG8_BAR
#undef PG8_SCHED
}
}

#define GAS __attribute__((address_space(1)))
#define LAS __attribute__((address_space(3)))
typedef unsigned short bf16;
typedef unsigned v4u __attribute__((ext_vector_type(4)));
typedef float f32x4 __attribute__((ext_vector_type(4)));
typedef short bf16x8 __attribute__((ext_vector_type(8)));
typedef short s16x4 __attribute__((ext_vector_type(4)));
typedef float f32x16 __attribute__((ext_vector_type(16)));

constexpr int NWAVES = 8;
constexpr int NB = 16, SEQ = 4096, NTOK = NB * SEQ, DMODEL = 1024, DIN = 4256, DINP = 4352, DFF = 4096;
constexpr float LOG2E = 1.4426950408889634f;
constexpr float C2D = 0.125f * LOG2E;
constexpr float C2M = 0.10206207261596577f * LOG2E;
constexpr float ALPHA = 1.189207115002721f;
constexpr float LN_EPS = 1e-5f, RMS_EPS = 1e-6f;
constexpr float NLOG2E = -1.4426950408889634f;
constexpr int LH_GB = 131072 + 1024;
constexpr float LAMBDA_INIT = 0.2f;

constexpr size_t MiB = 1u << 20;
constexpr size_t WS_XB = 0, WS_DQ = 128 * MiB, WS_DK = 192 * MiB, WS_DV = 256 * MiB, WS_CQ = 320 * MiB, WS_CKV = 368 * MiB, WS_KR = 400 * MiB,
                 WS_G = 404 * MiB, WS_QM = 660 * MiB, WS_KV = 756 * MiB;
constexpr size_t WS_OD = 0, WS_OM = 64 * MiB, WS_Y = 128 * MiB, WS_X1 = 0, WS_X1B = 256 * MiB, WS_H = 384 * MiB;
constexpr size_t WS_WIN = 900 * MiB, WS_WUQ = 909 * MiB, WS_WUKV = 910 * MiB, WS_WOD = 911 * MiB, WS_WOM = 912 * MiB, WS_WOUT = 913 * MiB,
                 WS_WUP = 915 * MiB, WS_WDN = 923 * MiB, WS_TD = 931 * MiB, WS_TM = 935 * MiB, WS_SSQ = 943 * MiB, WS_O1 = 948 * MiB, WS_END = 980 * MiB;
constexpr size_t WS_CTL = 896 * MiB, CTL_BYTES = 16384;

constexpr int RING_BYTES = 131072, LDS_BYTES = 147456;

struct Params {
    const float* x; const int* pos; const float* w_in; const float* gate_b; const float* diff_lambda; const float* subln_g; const float* qn_g; const float* w_uq;
    const float* kvn_g; const float* w_ukv; const float* w_od; const float* w_om; const float* w_out; const float* ln1_g; const float* ln1_b; const float* w_up; const float* w_dn;
    const float* ln2_g; const float* ln2_b;
    float* out; unsigned char* ws; float invf[24]; int s_lo, s_hi;
};

__device__ __forceinline__ unsigned f2bf(float f) { unsigned u = __builtin_bit_cast(unsigned, f); return (u + 0x7fffu + ((u >> 16) & 1u)) >> 16; }
__device__ __forceinline__ unsigned pk2(float lo, float hi) { return f2bf(lo) | (f2bf(hi) << 16); }
__device__ __forceinline__ float bf2f(unsigned short h) { return __builtin_bit_cast(float, (unsigned)h << 16); }
__device__ __forceinline__ float shxl(float v, int m, int lane) { return __builtin_bit_cast(float, __builtin_amdgcn_ds_bpermute((lane ^ m) << 2, __builtin_bit_cast(int, v))); }
__device__ __forceinline__ float wave_sum(float v, int lane) {
#pragma unroll
    for (int o = 1; o < 64; o <<= 1) v += shxl(v, o, lane);
    return v;
}

struct Epi {
    static constexpr bool PERM = true, AFTER_DRAIN = false;
    int mode; const __attribute__((address_space(4))) Params* kp; PG8_LAS unsigned char* lds;
    __device__ __forceinline__ static void st8_nt(bf16* p, pg8::f32x4 v0, pg8::f32x4 v1) {
        pg8::u32x4 w; w.x = pg8::cvt_pk_bf16(v0[0], v0[1]); w.y = pg8::cvt_pk_bf16(v0[2], v0[3]); w.z = pg8::cvt_pk_bf16(v1[0], v1[1]); w.w = pg8::cvt_pk_bf16(v1[2], v1[3]);
        __builtin_nontemporal_store(w, (pg8::u32x4*)p);
    }
    __device__ __forceinline__ static void st8(bf16* p, pg8::f32x4 v0, pg8::f32x4 v1) {
        pg8::u32x4 w; w.x = pg8::cvt_pk_bf16(v0[0], v0[1]); w.y = pg8::cvt_pk_bf16(v0[2], v0[3]); w.z = pg8::cvt_pk_bf16(v1[0], v1[1]); w.w = pg8::cvt_pk_bf16(v1[2], v1[3]);
        *(pg8::u32x4*)p = w;
    }
    __device__ __forceinline__ static void ld8(const bf16* p, pg8::f32x4& v0, pg8::f32x4& v1) {
        const pg8::u32x4 w = *(const pg8::u32x4*)p;
        v0[0] = __builtin_bit_cast(float, w.x << 16); v0[1] = __builtin_bit_cast(float, w.x & 0xffff0000u); v0[2] = __builtin_bit_cast(float, w.y << 16); v0[3] = __builtin_bit_cast(float, w.y & 0xffff0000u);
        v1[0] = __builtin_bit_cast(float, w.z << 16); v1[1] = __builtin_bit_cast(float, w.z & 0xffff0000u); v1[2] = __builtin_bit_cast(float, w.w << 16); v1[3] = __builtin_bit_cast(float, w.w & 0xffff0000u);
    }
    __device__ __forceinline__ static float px(float v, int m, int lane) {
        const unsigned u = __builtin_bit_cast(unsigned, v);
        if (m == 32) { auto rr = __builtin_amdgcn_permlane32_swap(u, u, false, false); return __builtin_bit_cast(float, (lane & 32) ? (unsigned)rr[0] : (unsigned)rr[1]); }
        else { auto rr = __builtin_amdgcn_permlane16_swap(u, u, false, false); return __builtin_bit_cast(float, (lane & 16) ? (unsigned)rr[0] : (unsigned)rr[1]); }
    }
    __device__ __forceinline__ static pg8::f32x4 shx(pg8::f32x4 v, int m, int lane) { pg8::f32x4 r; r[0] = px(v[0], m, lane); r[1] = px(v[1], m, lane); r[2] = px(v[2], m, lane); r[3] = px(v[3], m, lane); return r; }
    __device__ __forceinline__ static void rope32(pg8::f32x4& v0, pg8::f32x4& v1, const float* trow, int fq, int lane) {
        const pg8::f32x4 q0 = shx(v0, 32, lane), q1 = shx(v1, 32, lane);
        const int i0 = 8 * (fq & 1); const float sg = fq < 2 ? -1.f : 1.f;
        const pg8::f32x4 c0 = *(const pg8::f32x4*)(trow + i0), c1 = *(const pg8::f32x4*)(trow + i0 + 4), s0 = *(const pg8::f32x4*)(trow + 16 + i0), s1 = *(const pg8::f32x4*)(trow + 16 + i0 + 4);
        v0 = v0 * c0 + (q0 * s0) * sg; v1 = v1 * c1 + (q1 * s1) * sg;
    }
    __device__ __forceinline__ void mid(pg8::f32x4 (&acc)[2][2][4][2], const pg8::Unit& u, int wr_, int wc_, int fr_, int fq_) const {
        using pg8::f32x4; using pg8::BM; using pg8::HALF;
        int wr = wr_, wc = wc_, fr = fr_, fq = fq_; asm volatile("" : "+s"(wr), "+s"(wc), "+v"(fr), "+v"(fq));
        unsigned char* const ws = kp->ws; const bf16* const G = (const bf16*)(ws + WS_G);
        const int row0 = u.pm * BM + wr * 64 + fr;
#pragma unroll
        for (int bj = 0; bj < 2; ++bj) { const int c0 = u.pn * BM + bj * HALF + wc * 32 + 8 * fq;
#pragma unroll
            for (int ai = 0; ai < 2; ++ai)
#pragma unroll
                for (int m = 0; m < 4; ++m) { const int row = row0 + ai * HALF + m * 16; f32x4 g0a, g0b, g1a, g1b;
                    ld8(G + (size_t)row * 2048 + c0, g0a, g0b); ld8(G + (size_t)row * 2048 + 1024 + c0, g1a, g1b);
#pragma unroll
                    for (int j = 0; j < 4; ++j) { acc[ai][bj][m][0][j] *= g0a[j] * __builtin_amdgcn_rcpf(g1a[j]); acc[ai][bj][m][1][j] *= g0b[j] * __builtin_amdgcn_rcpf(g1b[j]); } } }
    }
    __device__ __forceinline__ void init(pg8::f32x4 (&acc)[2][2][4][2], const pg8::Unit& u, int wr, int wc, int fq) const {
        if (mode != 0) return;
#pragma unroll
        for (int bj = 0; bj < 2; ++bj) { const int c32 = u.pn * pg8::BM + bj * pg8::HALF + wc * 32;
            if (c32 >= 2208 && c32 < DIN) { const PG8_LAS float* gb = (const PG8_LAS float*)(lds + LH_GB) + (c32 - 2208) + 8 * fq;
                const pg8::f32x4 b0 = *(const PG8_LAS pg8::f32x4*)gb, b1 = *(const PG8_LAS pg8::f32x4*)(gb + 4);
#pragma unroll
                for (int ai = 0; ai < 2; ++ai)
#pragma unroll
                    for (int m = 0; m < 4; ++m) { acc[ai][bj][m][0] = b0; acc[ai][bj][m][1] = b1; } } }
    }
    __device__ __forceinline__ void operator()(const pg8::f32x4 (&acc)[2][2][4][2], const pg8::Unit& u, int wr_, int wc_, int fr_, int fq_) const {
        using pg8::f32x4; using pg8::BM; using pg8::HALF;
        int wr = wr_, wc = wc_, fr = fr_, fq = fq_; asm volatile("" : "+s"(wr), "+s"(wc), "+v"(fr), "+v"(fq));
        const int row0 = u.pm * BM + wr * 64 + fr, lane = fq * 16 + fr;
        unsigned char* const ws = kp->ws;
        bf16* const DQ = (bf16*)(ws + WS_DQ); bf16* const DK = (bf16*)(ws + WS_DK); bf16* const DV = (bf16*)(ws + WS_DV); bf16* const CQ = (bf16*)(ws + WS_CQ);
        bf16* const CKV = (bf16*)(ws + WS_CKV); bf16* const KR = (bf16*)(ws + WS_KR); bf16* const G = (bf16*)(ws + WS_G); bf16* const QM = (bf16*)(ws + WS_QM); bf16* const KV = (bf16*)(ws + WS_KV);
        bf16* const Y = (bf16*)(ws + WS_Y); bf16* const H = (bf16*)(ws + WS_H);
        float* const SSQ = (float*)(ws + WS_SSQ); const float* const TD = (const float*)(ws + WS_TD); const float* const TM = (const float*)(ws + WS_TM);
        if (mode == 0) {
#pragma unroll
            for (int bj = 0; bj < 2; ++bj) {
                const int c32 = u.pn * BM + bj * HALF + wc * 32, c0 = c32 + 8 * fq;
                if (c32 < 1024) {
                    bf16* dst = (c32 < 512) ? DQ : DK; const float sc = (c32 < 512) ? C2D : 1.f; const int cc = c0 & 511; const bool rope = (c32 & 32) == 0;
#pragma unroll
                    for (int ai = 0; ai < 2; ++ai)
#pragma unroll
                        for (int m = 0; m < 4; ++m) { const int row = row0 + ai * HALF + m * 16; f32x4 v0 = acc[ai][bj][m][0], v1 = acc[ai][bj][m][1];
                            if (rope) { const f32x4 q0 = shx(v0, 16, lane), q1 = shx(v1, 16, lane);
                                if (fq < 2) { const float* t = TD + (size_t)row * 16; const float sg = fq == 0 ? -1.f : 1.f;
                                    const f32x4 cs0 = *(const f32x4*)(t), cs1 = *(const f32x4*)(t + 4), sn0 = *(const f32x4*)(t + 8), sn1 = *(const f32x4*)(t + 12);
                                    v0 = v0 * cs0 + (q0 * sn0) * sg; v1 = v1 * cs1 + (q1 * sn1) * sg; } }
                            st8_nt(dst + (size_t)row * 512 + cc, v0 * sc, v1 * sc); }
                } else if (c32 < 1536) {
#pragma unroll
                    for (int ai = 0; ai < 2; ++ai)
#pragma unroll
                        for (int m = 0; m < 4; ++m) { const int row = row0 + ai * HALF + m * 16; st8_nt(DV + (size_t)row * 512 + (c0 - 1024), acc[ai][bj][m][0], acc[ai][bj][m][1]); }
                } else if (c32 < 2176) {
                    const bool isq = c32 < 1920; bf16* dst = isq ? CQ : CKV; const int pitch = isq ? 384 : 256, cc = isq ? c0 - 1536 : c0 - 1920, slot = isq ? (c32 - 1536) / 32 : 12 + (c32 - 1920) / 32;
#pragma unroll
                    for (int ai = 0; ai < 2; ++ai)
#pragma unroll
                        for (int m = 0; m < 4; ++m) { const int row = row0 + ai * HALF + m * 16; const f32x4 v0 = acc[ai][bj][m][0], v1 = acc[ai][bj][m][1];
                            float s = (v0[0] * v0[0] + v0[1] * v0[1]) + (v0[2] * v0[2] + v0[3] * v0[3]) + (v1[0] * v1[0] + v1[1] * v1[1]) + (v1[2] * v1[2] + v1[3] * v1[3]);
                            s += px(s, 16, lane); s += px(s, 32, lane);
                            if (fq == 0) SSQ[(size_t)row * 20 + slot] = s;
                            st8(dst + (size_t)row * pitch + cc, v0, v1); }
                } else if (c32 < 2208) {
#pragma unroll
                    for (int ai = 0; ai < 2; ++ai)
#pragma unroll
                        for (int m = 0; m < 4; ++m) { const int row = row0 + ai * HALF + m * 16; f32x4 v0 = acc[ai][bj][m][0], v1 = acc[ai][bj][m][1];
                            rope32(v0, v1, TM + (size_t)row * 32, fq, lane); st8(KR + (size_t)row * 32 + 8 * fq, v0, v1); }
                } else if (c32 < DIN) {
                    const int gc = c0 - 2208;
#pragma unroll
                    for (int ai = 0; ai < 2; ++ai)
#pragma unroll
                        for (int m = 0; m < 4; ++m) { const int row = row0 + ai * HALF + m * 16; f32x4 v0 = acc[ai][bj][m][0], v1 = acc[ai][bj][m][1];
#pragma unroll
                            for (int j = 0; j < 4; ++j) { v0[j] = __builtin_amdgcn_rcpf(1.f + __builtin_amdgcn_exp2f(v0[j])); v1[j] = __builtin_amdgcn_rcpf(1.f + __builtin_amdgcn_exp2f(v1[j])); }
                            st8_nt(G + (size_t)row * 2048 + gc, v0, v1); }
                }
            }
        } else if (mode == 1 || mode == 2) {
            float rs[2][4];
#pragma unroll
            for (int ai = 0; ai < 2; ++ai)
#pragma unroll
                for (int m = 0; m < 4; ++m) { const float* sp = SSQ + (size_t)(row0 + ai * HALF + m * 16) * 20;
                    if (mode == 1) { const f32x4 a = *(const f32x4*)(sp), b = *(const f32x4*)(sp + 4), c = *(const f32x4*)(sp + 8);
                        const float t = ((a[0] + a[1]) + (a[2] + a[3])) + ((b[0] + b[1]) + (b[2] + b[3])) + ((c[0] + c[1]) + (c[2] + c[3])); rs[ai][m] = 1.0f / sqrtf(t * (1.f / 384.f) + RMS_EPS); }
                    else { const f32x4 a = *(const f32x4*)(sp + 12), b = *(const f32x4*)(sp + 16);
                        const float t = ((a[0] + a[1]) + (a[2] + a[3])) + ((b[0] + b[1]) + (b[2] + b[3])); rs[ai][m] = 1.0f / sqrtf(t * (1.f / 256.f) + RMS_EPS); } }
#pragma unroll
            for (int bj = 0; bj < 2; ++bj) {
                const int c32 = u.pn * BM + bj * HALF + wc * 32, c0 = c32 + 8 * fq; const bool rope = (mode == 1) && ((c32 >> 5) % 3 == 2);
#pragma unroll
                for (int ai = 0; ai < 2; ++ai)
#pragma unroll
                    for (int m = 0; m < 4; ++m) { const int row = row0 + ai * HALF + m * 16; f32x4 v0 = acc[ai][bj][m][0] * rs[ai][m], v1 = acc[ai][bj][m][1] * rs[ai][m];
                        if (mode == 1) { if (rope) rope32(v0, v1, TM + (size_t)row * 32, fq, lane); st8_nt(QM + (size_t)row * 768 + c0, v0 * C2M, v1 * C2M); }
                        else st8(KV + (size_t)row * 1024 + c0, v0, v1); }
            }
        } else if (mode == 7) {
            bf16* const X1B = (bf16*)(ws + WS_X1B);
#pragma unroll
            for (int bj = 0; bj < 2; ++bj) { const int c0 = u.pn * BM + bj * HALF + wc * 32 + 8 * fq;
#pragma unroll
                for (int ai = 0; ai < 2; ++ai)
#pragma unroll
                    for (int m = 0; m < 4; ++m) { const int row = row0 + ai * HALF + m * 16; bf16* p = X1B + (size_t)row * 1024 + c0; f32x4 x0, x1;
                        ld8(p, x0, x1); st8(p, x0 * ALPHA + acc[ai][bj][m][0], x1 * ALPHA + acc[ai][bj][m][1]); } }
        } else {
            float* const out = kp->out; const float* const x = kp->x;
#pragma unroll
            for (int bj = 0; bj < 2; ++bj) {
                const int c0 = u.pn * BM + bj * HALF + wc * 32 + 8 * fq;
#pragma unroll
                for (int ai = 0; ai < 2; ++ai)
#pragma unroll
                    for (int m = 0; m < 4; ++m) { const int row = row0 + ai * HALF + m * 16; const f32x4 a0 = acc[ai][bj][m][0], a1 = acc[ai][bj][m][1];
                        float* o = out + (size_t)row * 1024 + c0;
                        if (mode == 3) { f32x4 g0, g1; ld8(G + (size_t)row * 2048 + 1024 + c0, g0, g1); st8(Y + (size_t)row * 1024 + c0, a0 * g0, a1 * g1); }
                        else if (mode == 5) { const float* xr = x + (size_t)row * 1024 + c0; st8((bf16*)(ws + WS_X1B) + (size_t)row * 1024 + c0, __builtin_nontemporal_load((const f32x4*)xr) * ALPHA + a0, __builtin_nontemporal_load((const f32x4*)(xr + 4)) * ALPHA + a1); }
                        else if (mode == 6) { f32x4 r0, r1;
#pragma unroll
                            for (int j = 0; j < 4; ++j) { const float t0 = fmaxf(a0[j], 0.f), t1 = fmaxf(a1[j], 0.f); r0[j] = t0 * t0; r1[j] = t1 * t1; }
                            st8_nt(H + (size_t)row * DFF + c0, r0, r1); }
                        else { } }
            }
        }
    }
};

namespace att {
typedef LAS const char* lds_cptr;
typedef float f32x2_t __attribute__((ext_vector_type(2))); typedef __bf16 bf16x2_t __attribute__((ext_vector_type(2)));
__device__ __forceinline__ int crow(int r, int hi) { return (r & 3) + 8 * (r >> 2) + 4 * hi; }
__device__ __forceinline__ unsigned cvtpk_s(float lo, float hi) { f32x2_t v = {lo, hi}; bf16x2_t b = __builtin_convertvector(v, bf16x2_t); return __builtin_bit_cast(unsigned, b); }
__device__ __forceinline__ void glds16(const void* gsrc, unsigned lds_dst) { unsigned keep;
    asm volatile("s_mov_b32 %0, m0\n\ts_mov_b32 m0, %2\n\ts_nop 0\n\tglobal_load_lds_dwordx4 %1, off\n\ts_mov_b32 m0, %0" : "=&s"(keep) : "v"(gsrc), "s"(lds_dst) : "memory"); }
constexpr int L_K = 0, KSLOT = 12288, L_V = 24576, VSLOT = 16384, L_WS = 57344;
struct Src { const bf16* Q; int qp; const bf16* K1; int k1p; const bf16* K2; int k2p; const bf16* V; int vp; };

typedef short v4i16_t __attribute__((ext_vector_type(4)));
__device__ __forceinline__ s16x4 vtr(lds_cptr p) { return __builtin_bit_cast(s16x4, __builtin_amdgcn_ds_read_tr16_b64_v4i16((LAS v4i16_t*)p)); }

template <int DQK>
__device__ __forceinline__ void qk_tile(lds_cptr kb, const bf16x8 (&qr)[DQK / 16], f32x16& p0, f32x16& p1) {
    p0 = f32x16{}; p1 = f32x16{};
#pragma unroll
    for (int d0 = 0; d0 < DQK / 16; ++d0) { const bf16x8 b0 = *(const LAS bf16x8*)(kb + d0 * 2048), b1 = *(const LAS bf16x8*)(kb + d0 * 2048 + 512);
        p0 = __builtin_amdgcn_mfma_f32_32x32x16_bf16(b0, qr[d0], p0, 0, 0, 0); p1 = __builtin_amdgcn_mfma_f32_32x32x16_bf16(b1, qr[d0], p1, 0, 0, 0); }
}

__device__ __forceinline__ float max_halves(float v) { const unsigned u = __builtin_bit_cast(unsigned, v); auto rr = __builtin_amdgcn_permlane32_swap(u, u, false, false);
    return fmaxf(__builtin_bit_cast(float, (unsigned)rr[0]), __builtin_bit_cast(float, (unsigned)rr[1])); }
#define ATT_FENCE() __builtin_amdgcn_sched_barrier(0)

template <int DQK, int DV, bool MASKN, int THR>
__device__ __forceinline__ void attn_step(lds_cptr kb_next, lds_cptr vb, const bf16x8 (&qr)[DQK / 16], f32x16& c0, f32x16& c1, f32x16& n0, f32x16& n1, float& rm,
                                          f32x16& negm, float& mhat, f32x16 (&o)[DV / 32], float& l_run, LAS float* wsf, int t, int qabs, int r32, int hi) {
    constexpr int ND = DQK / 16;
    if (__any(rm > (float)THR)) {
        const float dl = fmaxf(rm, 0.f); mhat += dl;
#pragma unroll
        for (int r = 0; r < 16; ++r) { c0[r] -= dl; c1[r] -= dl; negm[r] = -mhat; }
        const float f = __builtin_amdgcn_exp2f(-dl); l_run *= f;
        if (hi == 0) wsf[r32] = f;
#pragma unroll
        for (int k = 0; k < 4; ++k) { const f32x4 a = *(const LAS f32x4*)(wsf + 8 * k + 4 * hi);
#pragma unroll
            for (int d = 0; d < DV / 32; ++d) { o[d][4 * k] *= a[0]; o[d][4 * k + 1] *= a[1]; o[d][4 * k + 2] *= a[2]; o[d][4 * k + 3] *= a[3]; } }
    }
    bf16x8 b0 = *(const LAS bf16x8*)(kb_next), b1 = *(const LAS bf16x8*)(kb_next + 512);
    ATT_FENCE();
#pragma unroll
    for (int d0 = 0; d0 < ND; ++d0) {
        bf16x8 nb0 = b0, nb1 = b1;
        if (d0 + 1 < ND) { nb0 = *(const LAS bf16x8*)(kb_next + (d0 + 1) * 2048); nb1 = *(const LAS bf16x8*)(kb_next + (d0 + 1) * 2048 + 512); }
        if (d0 == 0) { n0 = __builtin_amdgcn_mfma_f32_32x32x16_bf16(b0, qr[0], negm, 0, 0, 0); n1 = __builtin_amdgcn_mfma_f32_32x32x16_bf16(b1, qr[0], negm, 0, 0, 0); }
        else { n0 = __builtin_amdgcn_mfma_f32_32x32x16_bf16(b0, qr[d0], n0, 0, 0, 0); n1 = __builtin_amdgcn_mfma_f32_32x32x16_bf16(b1, qr[d0], n1, 0, 0, 0); }
#pragma unroll
        for (int e = (8 * d0) / ND; e < (8 * (d0 + 1)) / ND; ++e) c0[e] = __builtin_amdgcn_exp2f(c0[e]);
        ATT_FENCE();
        b0 = nb0; b1 = nb1;
    }
    float sum = 0.f, rmn = -INFINITY;
    int thr = qabs - 64 * (t + 1) - 4 * hi; asm volatile("" : "+v"(thr));
    if constexpr (DV == 64) {
    constexpr int NSG = DV / 64;
#pragma unroll
    for (int ks = 0; ks < 4; ++ks) {
        f32x16& src = (ks < 2) ? c0 : c1; const int base = (ks & 1) * 8;
        const v4u pw = (v4u){cvtpk_s(src[base], src[base + 1]), cvtpk_s(src[base + 2], src[base + 3]), cvtpk_s(src[base + 4], src[base + 5]), cvtpk_s(src[base + 6], src[base + 7])};
#pragma unroll
        for (int sg = 0; sg < NSG; ++sg) {
            s16x4 lo[2], hh[2];
#pragma unroll
            for (int e = 0; e < 2; ++e) { lo[e] = vtr(vb + (2 * sg + e) * 4096 + ks * 1024); hh[e] = vtr(vb + (2 * sg + e) * 4096 + ks * 1024 + 512); }
            ATT_FENCE();
            if (sg == 0 && ks < 3) { f32x16& nsrc = (ks + 1 < 2) ? c0 : c1; const int nbase = ((ks + 1) & 1) * 8;
#pragma unroll
                for (int j = 0; j < 8; ++j) nsrc[nbase + j] = __builtin_amdgcn_exp2f(nsrc[nbase + j]); }
            if (sg == NSG - 1) {
#pragma unroll
                for (int j = 0; j < 8; ++j) sum += src[base + j];
                f32x16& nx = (ks < 2) ? n0 : n1;
#pragma unroll
                for (int j = 0; j < 8; ++j) { const int r = base + j;
                    if (MASKN) { if ((r & 3) + 8 * (r >> 2) + ((ks < 2) ? 0 : 32) > thr) nx[r] = -INFINITY; }
                    rmn = fmaxf(rmn, nx[r]); } }
            ATT_FENCE();
#pragma unroll
            for (int e = 0; e < 2; ++e) { const bf16x8 vf = (bf16x8){lo[e][0], lo[e][1], lo[e][2], lo[e][3], hh[e][0], hh[e][1], hh[e][2], hh[e][3]};
                o[2 * sg + e] = __builtin_amdgcn_mfma_f32_32x32x16_bf16(__builtin_bit_cast(bf16x8, pw), vf, o[2 * sg + e], 0, 0, 0); }
            ATT_FENCE();
        }
    }
    } else {
#pragma unroll
    for (int ks = 0; ks < 4; ++ks) {
        f32x16& src = (ks < 2) ? c0 : c1; const int base = (ks & 1) * 8;
        const v4u pw = (v4u){cvtpk_s(src[base], src[base + 1]), cvtpk_s(src[base + 2], src[base + 3]), cvtpk_s(src[base + 4], src[base + 5]), cvtpk_s(src[base + 6], src[base + 7])};
#pragma unroll
        for (int d0 = 0; d0 < DV / 32; ++d0) { const s16x4 lo = vtr(vb + d0 * 4096 + ks * 1024), hh = vtr(vb + d0 * 4096 + ks * 1024 + 512);
            const bf16x8 vf = (bf16x8){lo[0], lo[1], lo[2], lo[3], hh[0], hh[1], hh[2], hh[3]};
            o[d0] = __builtin_amdgcn_mfma_f32_32x32x16_bf16(__builtin_bit_cast(bf16x8, pw), vf, o[d0], 0, 0, 0); }
        if (ks < 3) { f32x16& nsrc = (ks + 1 < 2) ? c0 : c1; const int nbase = ((ks + 1) & 1) * 8;
#pragma unroll
            for (int j = 0; j < 8; ++j) nsrc[nbase + j] = __builtin_amdgcn_exp2f(nsrc[nbase + j]); }
#pragma unroll
        for (int j = 0; j < 8; ++j) sum += src[base + j];
        { f32x16& nx = (ks < 2) ? n0 : n1;
#pragma unroll
          for (int j = 0; j < 8; ++j) { const int r = base + j;
              if (MASKN) { if ((r & 3) + 8 * (r >> 2) + ((ks < 2) ? 0 : 32) > thr) nx[r] = -INFINITY; }
              rmn = fmaxf(rmn, nx[r]); } }
        ATT_FENCE();
    }
    }
    l_run += sum;
    rm = max_halves(rmn);
}

template <int DQK, int DV, int NK1>
__device__ __forceinline__ void attn_core(const Src& s, int q0, char* shm, f32x16 (&o)[DV / 32], const int tid_in) {
    constexpr int THR = 8;
    const int tid = tid_in, lane = tid & 63, r32 = lane & 31, hi = lane >> 5; const int wid = __builtin_amdgcn_readfirstlane(tid >> 6);
    const unsigned lds0 = (unsigned)(uintptr_t)shm;
    LAS float* wsf = (LAS float*)((LAS char*)shm + L_WS) + wid * 64;
    constexpr int NKC = DQK / 8, NVP = DV / 8;
#define ATT_DMA_K(t, slot) do { \
        _Pragma("unroll") for (int c_ = 0; c_ < (NKC + 7) / 8; ++c_) { const int ch = wid + 8 * c_; if (ch < NKC) { \
            const bf16* src_ = (ch < NK1) ? s.K1 + (size_t)(64 * (t) + lane) * s.k1p + ch * 8 : s.K2 + (size_t)(64 * (t) + lane) * s.k2p + (ch - NK1) * 8; \
            glds16(src_, (unsigned)__builtin_amdgcn_readfirstlane(lds0 + L_K + (slot) * KSLOT + ch * 1024)); } } } while (0)
#define ATT_DMA_V(t, slot) do { \
        _Pragma("unroll") for (int c_ = 0; c_ < NVP / 8; ++c_) { const int p_ = wid + 8 * c_; const int db = p_ >> 2, rg = p_ & 3; \
            const bf16* src_ = s.V + (size_t)(64 * (t) + 16 * rg + (lane >> 2)) * s.vp + 32 * db + (lane & 3) * 8; \
            glds16(src_, (unsigned)__builtin_amdgcn_readfirstlane(lds0 + L_V + (slot) * VSLOT + p_ * 1024)); } } while (0)
#define ATT_BAR() asm volatile("s_waitcnt vmcnt(0) lgkmcnt(0)\n\ts_barrier" ::: "memory")
    ATT_DMA_K(0, 0); ATT_DMA_V(0, 0); ATT_DMA_K(1, 1);
    bf16x8 qr[DQK / 16];
#pragma unroll
    for (int d0 = 0; d0 < DQK / 16; ++d0) qr[d0] = *(const bf16x8*)(s.Q + (size_t)(q0 + wid * 32 + r32) * s.qp + d0 * 16 + hi * 8);
    float l_run = 0.f;
#pragma unroll
    for (int d = 0; d < DV / 32; ++d) o[d] = f32x16{};
    const int NT = (q0 + 256) / 64; const int qw0 = q0 + wid * 32, qabs = qw0 + r32;
    const int tlast = (qw0 + 31) >> 6;
    const lds_cptr kb0 = (lds_cptr)((LAS char*)shm) + L_K + hi * 1024 + r32 * 16;
    const lds_cptr vb0 = (lds_cptr)((LAS char*)shm) + L_V + ((lane >> 4) & 1) * 32 + (lane & 3) * 8 + (4 * hi + ((lane & 15) >> 2)) * 64;
    ATT_BAR();
    f32x16 a0, a1, b0_, b1_, negm; float rm, mhat;
    qk_tile<DQK>(kb0, qr, a0, a1);
    if (NT == 4) {
#pragma unroll
        for (int r = 0; r < 16; ++r) { const int thr0 = qabs - 4 * hi; if ((r & 3) + 8 * (r >> 2) > thr0) a0[r] = -INFINITY; if ((r & 3) + 8 * (r >> 2) + 32 > thr0) a1[r] = -INFINITY; }
    }
    { float v = fmaxf(a0[0], a1[0]);
#pragma unroll
      for (int r = 1; r < 16; ++r) v = fmaxf(v, fmaxf(a0[r], a1[r]));
      mhat = max_halves(v); rm = 0.f;
#pragma unroll
      for (int r = 0; r < 16; ++r) { a0[r] -= mhat; a1[r] -= mhat; negm[r] = -mhat; } }
    int t = 0;
    for (; t < NT - 6; t += 2) {
        ATT_BAR(); ATT_DMA_K(t + 2, 0); ATT_DMA_V(t + 1, 1);
        attn_step<DQK, DV, false, THR>(kb0 + KSLOT, vb0, qr, a0, a1, b0_, b1_, rm, negm, mhat, o, l_run, wsf, t, qabs, r32, hi);
        ATT_BAR(); ATT_DMA_K(t + 3, 1); ATT_DMA_V(t + 2, 0);
        attn_step<DQK, DV, false, THR>(kb0, vb0 + VSLOT, qr, b0_, b1_, a0, a1, rm, negm, mhat, o, l_run, wsf, t + 1, qabs, r32, hi);
    }
    for (; t < NT; t += 2) {
        ATT_BAR(); if (t + 2 < NT) ATT_DMA_K(t + 2, 0); ATT_DMA_V(t + 1, 1);
        if (t <= tlast) attn_step<DQK, DV, true, THR>(kb0 + KSLOT, vb0, qr, a0, a1, b0_, b1_, rm, negm, mhat, o, l_run, wsf, t, qabs, r32, hi);
        ATT_BAR(); if (t + 3 < NT) ATT_DMA_K(t + 3, 1); if (t + 2 < NT) ATT_DMA_V(t + 2, 0);
        if (t + 1 <= tlast) attn_step<DQK, DV, true, THR>(kb0, vb0 + VSLOT, qr, b0_, b1_, a0, a1, rm, negm, mhat, o, l_run, wsf, t + 1, qabs, r32, hi);
    }
#undef ATT_DMA_K
#undef ATT_DMA_V
#undef ATT_BAR
    l_run += shxl(l_run, 32, lane);
    if (hi == 0) wsf[32 + r32] = 1.0f / l_run;
#pragma unroll
    for (int k = 0; k < 4; ++k) { const f32x4 a = *(const LAS f32x4*)(wsf + 32 + 8 * k + 4 * hi);
#pragma unroll
        for (int d = 0; d < DV / 32; ++d) { o[d][4 * k] *= a[0]; o[d][4 * k + 1] *= a[1]; o[d][4 * k + 2] *= a[2]; o[d][4 * k + 3] *= a[3]; } }
}
}

#define RLX_AGENT __ATOMIC_RELAXED, __HIP_MEMORY_SCOPE_AGENT
#define XB_TMO      128
#define XB_XCNT(j)  (256  + 64 * (j))
#define XB_XSUB(j)  (1280 + 64 * (j))
#define XB_XGEN(j)  (2304 + 64 * (j))
#define XB_TOP      3328
#define XB_TOPGEN   3392
#define XCD_BAR_WORDS 3456
#define XB_SPIN_CAP (1u << 18)

__device__ __forceinline__ unsigned xb_ld(unsigned* p)              { return __hip_atomic_load(p, __ATOMIC_RELAXED, __HIP_MEMORY_SCOPE_AGENT); }
__device__ __forceinline__ unsigned xb_add(unsigned* p, unsigned v) { return __hip_atomic_fetch_add(p, v, __ATOMIC_RELAXED, __HIP_MEMORY_SCOPE_AGENT); }
__device__ __forceinline__ unsigned xb_xcc_id() { return (unsigned)__builtin_amdgcn_s_getreg((3 << 11) | 20) & 0xFu; }
#define XB_SPIN(cond, bar) do { unsigned _sp = 0; while (cond) { __builtin_amdgcn_s_sleep(1); \
    if ((++_sp & 255u) == 0u) { if (xb_ld(&(bar)[XB_TMO])) break; if (_sp > XB_SPIN_CAP) { atomicAdd(&(bar)[XB_TMO], 1u); break; } } } } while (0)

struct XcdBarrier {
    unsigned* bar; unsigned x;
    volatile LAS unsigned* st;
};

__device__ __forceinline__ XcdBarrier xcd_barrier_post(unsigned* bar, volatile LAS unsigned* st) {
    XcdBarrier b; b.bar = bar; b.x = xb_xcc_id(); b.st = st;
    if (threadIdx.x == 0) (void)xb_add(&bar[XB_XCNT(b.x)], 1u);
    return b;
}
__device__ __forceinline__ void xcd_barrier_complete(unsigned* bar, unsigned x, unsigned& nloc, unsigned& nx) {
    const unsigned G = gridDim.x * gridDim.y * gridDim.z;
    unsigned sum, cnt, mine, sp = 0u;
    for (;;) {
        sum = 0u; cnt = 0u; mine = 0u;
#pragma unroll
        for (unsigned j = 0; j < 16; ++j) { const unsigned c = xb_ld(&bar[XB_XCNT(j)]); sum += c; cnt += (c > 0u) ? 1u : 0u; mine = (j == x) ? c : mine; }
        if (sum == G) break;
        __builtin_amdgcn_s_sleep(1);
        if ((++sp & 255u) == 0u) { if (xb_ld(&bar[XB_TMO])) break; if (sp > XB_SPIN_CAP) { atomicAdd(&bar[XB_TMO], 1u); break; } }
    }
    nloc = mine > 0u ? mine : 1u; nx = cnt > 0u ? cnt : 1u;
}

__device__ __forceinline__ void xcd_barrier(const XcdBarrier b) {
    asm volatile("s_waitcnt vmcnt(0)" ::: "memory");
    __syncthreads();
    if (threadIdx.x == 0) {
        unsigned* bar = b.bar;
        __builtin_amdgcn_s_waitcnt(0);
        unsigned nloc = b.st[0], nx = b.st[1];
        if (nloc == 0u) { xcd_barrier_complete(bar, b.x, nloc, nx); b.st[0] = nloc; b.st[1] = nx; }
        const unsigned old = xb_add(&bar[XB_XSUB(b.x)], 1u);
        const unsigned gen = old / nloc;
        if (old + 1u == (gen + 1u) * nloc) {
            __builtin_amdgcn_fence(__ATOMIC_RELEASE, "agent");
            asm volatile("s_waitcnt vmcnt(0)" ::: "memory");
            const unsigned og = xb_add(&bar[XB_TOP], 1u);
            const unsigned tg = og / nx;
            if (og + 1u == (tg + 1u) * nx) xb_add(&bar[XB_TOPGEN], 1u);
            else XB_SPIN(xb_ld(&bar[XB_TOPGEN]) == tg, bar);
            __builtin_amdgcn_fence(__ATOMIC_ACQUIRE, "agent");
            xb_add(&bar[XB_XGEN(b.x)], 1u);
            asm volatile("s_waitcnt vmcnt(0)" ::: "memory");
        } else {
            XB_SPIN(xb_ld(&bar[XB_XGEN(b.x)]) == gen, bar);
            __builtin_amdgcn_fence(__ATOMIC_ACQUIRE, "agent");
            asm volatile("s_waitcnt vmcnt(0)" ::: "memory");
        }
    }
    __syncthreads();
}

__device__ __forceinline__ void p0_transpose_item(const float* W, const float* gain, int K, int N, bf16* WT, LAS float* scr, int item, int lane, int ldk = 0, int koff = 0, int nsc_from = 0x7fffffff) {
    if (ldk == 0) ldk = K;
    const int nblk = N / 32, kb = item / nblk, nb = item % nblk, k0 = 64 * kb, n0 = 32 * nb;
#pragma unroll 8
    for (int i = 0; i < 32; ++i) { const int kk = 2 * i + (lane >> 5); float v = __builtin_nontemporal_load(W + (size_t)(k0 + kk) * N + n0 + (lane & 31)); if (gain) v *= gain[k0 + kk]; if (n0 + (lane & 31) >= nsc_from) v *= NLOG2E; scr[kk * 33 + (lane & 31)] = v; }
    asm volatile("s_waitcnt lgkmcnt(0)" ::: "memory");
    const int c = lane & 7;
#pragma unroll
    for (int j = 0; j < 4; ++j) { const int n = (lane >> 3) + 8 * j; const LAS float* sp = scr + (8 * c) * 33 + n;
        v4u o; o.x = pk2(sp[0 * 33], sp[1 * 33]); o.y = pk2(sp[2 * 33], sp[3 * 33]); o.z = pk2(sp[4 * 33], sp[5 * 33]); o.w = pk2(sp[6 * 33], sp[7 * 33]);
        *(v4u*)(WT + (size_t)(n0 + n) * ldk + koff + k0 + 8 * c) = o; }
    asm volatile("s_waitcnt lgkmcnt(0)" ::: "memory");
}
__device__ __forceinline__ void sincos_red(float ang, float& c, float& sn) {
    const double rev = (double)ang * 0.15915494309189535; const float fr = (float)(rev - __builtin_rint(rev));
    c = __builtin_amdgcn_cosf(fr); sn = __builtin_amdgcn_sinf(fr);
}
template <int NR>
__device__ __forceinline__ void ln_rows_b(const bf16* src, bf16* d16, float* d32, size_t m0, size_t rstride, const float* g, const float* b, int lane) {
    v4u raw[NR][2]; f32x4 v[NR][4]; float mean[NR], rstd[NR];
#pragma unroll
    for (int i = 0; i < NR; ++i) { const bf16* r = src + (m0 + i * rstride) * 1024 + 8 * lane; if (d32) { raw[i][0] = __builtin_nontemporal_load((const v4u*)r); raw[i][1] = __builtin_nontemporal_load((const v4u*)(r + 512)); } else { raw[i][0] = *(const v4u*)r; raw[i][1] = *(const v4u*)(r + 512); } }
#pragma unroll
    for (int i = 0; i < NR; ++i) {
#pragma unroll
        for (int h = 0; h < 2; ++h) { const v4u w = raw[i][h];
            v[i][2 * h] = (f32x4){__builtin_bit_cast(float, w.x << 16), __builtin_bit_cast(float, w.x & 0xffff0000u), __builtin_bit_cast(float, w.y << 16), __builtin_bit_cast(float, w.y & 0xffff0000u)};
            v[i][2 * h + 1] = (f32x4){__builtin_bit_cast(float, w.z << 16), __builtin_bit_cast(float, w.z & 0xffff0000u), __builtin_bit_cast(float, w.w << 16), __builtin_bit_cast(float, w.w & 0xffff0000u)}; }
        float s = 0.f;
#pragma unroll
        for (int j = 0; j < 4; ++j) s += (v[i][j].x + v[i][j].y) + (v[i][j].z + v[i][j].w);
        mean[i] = wave_sum(s, lane) * (1.f / 1024.f); float s2 = 0.f;
#pragma unroll
        for (int j = 0; j < 4; ++j) { v[i][j] = v[i][j] - mean[i]; s2 += (v[i][j].x * v[i][j].x + v[i][j].y * v[i][j].y) + (v[i][j].z * v[i][j].z + v[i][j].w * v[i][j].w); }
        rstd[i] = 1.f / sqrtf(wave_sum(s2, lane) * (1.f / 1024.f) + LN_EPS); }
#pragma unroll
    for (int h = 0; h < 2; ++h) { const int c = 512 * h + 8 * lane;
        const f32x4 g0 = *(const f32x4*)(g + c), g1 = *(const f32x4*)(g + c + 4), b0 = *(const f32x4*)(b + c), b1 = *(const f32x4*)(b + c + 4);
#pragma unroll
        for (int i = 0; i < NR; ++i) { const f32x4 r0 = v[i][2 * h] * rstd[i] * g0 + b0, r1 = v[i][2 * h + 1] * rstd[i] * g1 + b1; const size_t off = (m0 + i * rstride) * 1024 + c;
            if (d16) *(v4u*)(d16 + off) = (v4u){pk2(r0.x, r0.y), pk2(r0.z, r0.w), pk2(r1.x, r1.y), pk2(r1.z, r1.w)};
            if (d32) { __builtin_nontemporal_store(r0, (f32x4*)(d32 + off)); __builtin_nontemporal_store(r1, (f32x4*)(d32 + off + 4)); } } }
}

__global__ void __launch_bounds__(NWAVES * 64, 2) mega_fwd(Params P_) {
    extern __shared__ __attribute__((aligned(16))) unsigned char lds[];
    cg::grid_group grid = cg::this_grid();
    const __attribute__((address_space(4))) Params* kp = (const __attribute__((address_space(4))) Params*)__builtin_amdgcn_kernarg_segment_ptr();
    asm volatile("" : "+s"(kp));
#define P (*kp)
    const int s_lo = P.s_lo, s_hi = P.s_hi;
    volatile LAS unsigned* const xb_st = (volatile LAS unsigned*)((LAS unsigned char*)lds + RING_BYTES + 64);
    if (s_hi - s_lo > 1) { if (threadIdx.x == 0) { xb_st[0] = 0u; xb_st[1] = 0u; } __syncthreads(); (void)xcd_barrier_post((unsigned*)(P.ws + WS_CTL), xb_st); }
    const int wave0 = __builtin_amdgcn_readfirstlane((int)threadIdx.x >> 6);
    for (int s = s_lo; s < s_hi; ++s) {
        int wv_ = wave0, bx_ = blockIdx.x, G_ = gridDim.x; asm volatile("" : "+s"(wv_), "+s"(bx_), "+s"(G_));
        const int wave = wv_;
#define LANE_ID() ({ int l_; asm volatile("v_mbcnt_lo_u32_b32 %0, -1, 0\n\tv_mbcnt_hi_u32_b32 %0, -1, %0" : "=v"(l_)); l_; })
        const int G = G_, bx = bx_, vcu = (G % 8 == 0) ? (bx % 8) * (G / 8) + bx / 8 : bx;
        unsigned char* const ws = P.ws;
        const int gw = vcu * NWAVES + wave, NGW = G * NWAVES;
        if (s == 0) {
            const int lane = LANE_ID(), tid = wave * 64 + lane;
            LAS float* scr = (LAS float*)((LAS unsigned char*)lds + wave * 16384);
            constexpr int I_IN = (1024 / 64) * (DIN / 32), I_UQ = (384 / 64) * (768 / 32), I_UKV = (256 / 64) * (1024 / 32), I_OD = (512 / 64) * (1024 / 32), I_OUT = (1024 / 64) * (1024 / 32),
                          I_UP = (1024 / 64) * (DFF / 32), I_DN = (DFF / 64) * (1024 / 32);
            constexpr int NITEMS = I_IN + I_UQ + I_UKV + 2 * I_OD + I_OUT + I_UP + I_DN;
            for (int it = gw; it < NITEMS; it += NGW) {
                int r = it;
                if (r < I_IN) { p0_transpose_item(P.w_in, nullptr, 1024, DIN, (bf16*)(ws + WS_WIN), scr, r, lane, 0, 0, 2208); continue; } r -= I_IN;
                if (r < I_UQ) { p0_transpose_item(P.w_uq, P.qn_g, 384, 768, (bf16*)(ws + WS_WUQ), scr, r, lane); continue; } r -= I_UQ;
                if (r < I_UKV) { p0_transpose_item(P.w_ukv, P.kvn_g, 256, 1024, (bf16*)(ws + WS_WUKV), scr, r, lane); continue; } r -= I_UKV;
                if (r < I_OD) { p0_transpose_item(P.w_od, nullptr, 512, 1024, (bf16*)(ws + WS_WOD), scr, r, lane, 1024, 0); continue; } r -= I_OD;
                if (r < I_OD) { p0_transpose_item(P.w_om, nullptr, 512, 1024, (bf16*)(ws + WS_WOD), scr, r, lane, 1024, 512); continue; } r -= I_OD;
                if (r < I_OUT) { p0_transpose_item(P.w_out, nullptr, 1024, 1024, (bf16*)(ws + WS_WOUT), scr, r, lane); continue; } r -= I_OUT;
                if (r < I_UP) { p0_transpose_item(P.w_up, nullptr, 1024, DFF, (bf16*)(ws + WS_WUP), scr, r, lane); continue; } r -= I_UP;
                p0_transpose_item(P.w_dn, nullptr, DFF, 1024, (bf16*)(ws + WS_WDN), scr, r, lane);
            }
            const int gt = vcu * (NWAVES * 64) + tid, NGT = G * NWAVES * 64;
            { v4u* z = (v4u*)(ws + WS_WIN + (size_t)DIN * 1024 * 2);
              for (int i = gt; i < (DINP - DIN) * 1024 * 2 / 16; i += NGT) { unsigned z_ = 0u; asm volatile("" : "+v"(z_)); z[i] = (v4u){z_, z_, z_, z_}; } }
            { const f32x4* xs = (const f32x4*)P.x; v4u* xd = (v4u*)(ws + WS_XB);
              for (int i = gt; i < NTOK * 1024 / 8; i += NGT) { const f32x4 a = __builtin_nontemporal_load(xs + 2 * i), b = __builtin_nontemporal_load(xs + 2 * i + 1); xd[i] = (v4u){pk2(a.x, a.y), pk2(a.z, a.w), pk2(b.x, b.y), pk2(b.z, b.w)}; } }
            { float* TD = (float*)(ws + WS_TD); float* TM = (float*)(ws + WS_TM);
              for (int i = gt; i < NTOK * 24; i += NGT) { const int tok = i / 24, j = i % 24; const float pf = (float)P.pos[tok];
                  if (j < 8) { const float inv = P.invf[j]; float c, sn; sincos_red(pf * inv, c, sn); TD[tok * 16 + j] = c; TD[tok * 16 + 8 + j] = sn; }
                  else { const int k = j - 8; const float inv = P.invf[j]; float c, sn; sincos_red(pf * inv, c, sn); TM[tok * 32 + k] = c; TM[tok * 32 + 16 + k] = sn; } } }
        } else if (s == 4) {
            const int lane = LANE_ID(), tid = wave * 64 + lane;
            char* shm = (char*)lds;
            const int r32 = lane & 31, hi = lane >> 5;
            float lamf;
            { const float* L = P.diff_lambda; const float a = wave_sum(L[lane] * L[64 + lane], lane), b = wave_sum(L[128 + lane] * L[192 + lane], lane); lamf = __expf(a) - __expf(b) + LAMBDA_INIT; }
            if (G == 256) {
                const int bh = vcu >> 2, sidx = vcu & 3, b = bh >> 2, h = bh & 3;
                const bf16* DQ = (const bf16*)(ws + WS_DQ) + (size_t)b * SEQ * 512 + h * 128; const bf16* DK = (const bf16*)(ws + WS_DK) + (size_t)b * SEQ * 512 + h * 128;
                const bf16* DV = (const bf16*)(ws + WS_DV) + (size_t)b * SEQ * 512 + h * 128; bf16* OD = (bf16*)(ws + WS_OD) + (size_t)b * SEQ * 1024 + h * 128;
                f32x4* scr1 = (f32x4*)(ws + WS_O1) + ((size_t)bx * 512 + tid) * 16;
                for (int i = 0; i < 4; ++i) {
                    const int qb = (i == 0) ? sidx : (i == 1) ? 7 - sidx : (i == 2) ? 8 + sidx : 15 - sidx; const int q0 = qb * 256;
                    for (int map = 0; map < 2; ++map) {
                        att::Src S{DQ + map * 64, 512, DK + map * 64, 512, DK, 512, DV, 512};
                        f32x16 o[4];
                        att::attn_core<64, 128, 8>(S, q0, shm, o, tid);
                        if (map == 0) {
#pragma unroll
                            for (int d = 0; d < 4; ++d)
#pragma unroll
                                for (int k = 0; k < 4; ++k) scr1[d * 4 + k] = (f32x4){o[d][4 * k], o[d][4 * k + 1], o[d][4 * k + 2], o[d][4 * k + 3]};
                        } else {
                            float ss[16];
#pragma unroll
                            for (int r = 0; r < 16; ++r) ss[r] = 0.f;
#pragma unroll
                            for (int d = 0; d < 4; ++d)
#pragma unroll
                                for (int k = 0; k < 4; ++k) { const f32x4 a = scr1[d * 4 + k];
#pragma unroll
                                    for (int j = 0; j < 4; ++j) { const float v = a[j] - lamf * o[d][4 * k + j]; o[d][4 * k + j] = v; ss[4 * k + j] += v * v; } }
#pragma unroll
                            for (int r = 0; r < 16; ++r) { float v = ss[r];
#pragma unroll
                                for (int mk = 1; mk < 32; mk <<= 1) v += shxl(v, mk, lane);
                                ss[r] = (1.0f / sqrtf(v * (1.f / 128.f) + RMS_EPS)) * (1.0f - LAMBDA_INIT); }
                            float gsub[4];
#pragma unroll
                            for (int d = 0; d < 4; ++d) gsub[d] = P.subln_g[32 * d + r32];
                            const int hi_e = LANE_ID() >> 5;
#pragma unroll
                            for (int r = 0; r < 16; ++r) { const int rr = att::crow(r, hi_e); bf16* op = OD + (size_t)(q0 + wave * 32 + rr) * 1024 + r32;
#pragma unroll
                                for (int d = 0; d < 4; ++d) op[32 * d] = (bf16)f2bf(o[d][r] * ss[r] * gsub[d]); }
                        }
                    }
                }
                {
                    const int bh2 = vcu >> 1, s2 = vcu & 1, b2 = bh2 >> 3, h2 = bh2 & 7;
                    const bf16* QM = (const bf16*)(ws + WS_QM) + (size_t)b2 * SEQ * 768 + h2 * 96; const bf16* KV = (const bf16*)(ws + WS_KV) + (size_t)b2 * SEQ * 1024 + h2 * 128;
                    const bf16* KR = (const bf16*)(ws + WS_KR) + (size_t)b2 * SEQ * 32; bf16* OM = (bf16*)(ws + WS_OD) + (size_t)b2 * SEQ * 1024 + 512 + h2 * 64;
                    for (int i = 0; i < 8; ++i) {
                        const int pr = i >> 1, qb = (i & 1) ? (4 * pr + 3 - s2) : (4 * pr + s2); const int q0 = qb * 256;
                        att::Src S{QM, 768, KV, 1024, KR, 32, KV + 64, 1024};
                        f32x16 o[2];
                        att::attn_core<96, 64, 8>(S, q0, shm, o, tid);
                        const int hi_e = LANE_ID() >> 5;
#pragma unroll
                        for (int r = 0; r < 16; ++r) { const int rr = att::crow(r, hi_e); bf16* op = OM + (size_t)(q0 + wave * 32 + rr) * 1024 + r32;
                            op[0] = (bf16)f2bf(o[0][r]); op[32] = (bf16)f2bf(o[1][r]); }
                    }
                }
            }
        } else if (s == 8 || s == 11) {
            const int lane = LANE_ID();
            bf16* const XB1 = (bf16*)(ws + WS_X1B);
            if (s == 8) { for (int m = gw; m < NTOK / 4; m += NGW) ln_rows_b<4>(XB1, XB1, nullptr, (size_t)m, (size_t)(NTOK / 4), P.ln1_g, P.ln1_b, lane); }
            else { for (int m = gw; m < NTOK / 4; m += NGW) ln_rows_b<4>(XB1, nullptr, P.out, (size_t)m, (size_t)(NTOK / 4), P.ln2_g, P.ln2_b, lane); }
        } else if (s == 6) {
        } else {
            const int tid = wave * 64 + LANE_ID();
            int mode; const bf16* A; const bf16* Bt; int N, K;
            switch (s) {
                case 1: mode = 0; A = (const bf16*)(ws + WS_XB); Bt = (const bf16*)(ws + WS_WIN); N = DINP; K = 1024; break;
                case 2: mode = 1; A = (const bf16*)(ws + WS_CQ); Bt = (const bf16*)(ws + WS_WUQ); N = 768; K = 384; break;
                case 3: mode = 2; A = (const bf16*)(ws + WS_CKV); Bt = (const bf16*)(ws + WS_WUKV); N = 1024; K = 256; break;
                case 5: mode = 3; A = (const bf16*)(ws + WS_OD); Bt = (const bf16*)(ws + WS_WOD); N = 1024; K = 1024; break;
                case 7: mode = 5; A = (const bf16*)(ws + WS_Y); Bt = (const bf16*)(ws + WS_WOUT); N = 1024; K = 1024; break;
                case 9: mode = 6; A = (const bf16*)(ws + WS_X1B); Bt = (const bf16*)(ws + WS_WUP); N = DFF; K = 1024; break;
                default: mode = 7; A = (const bf16*)(ws + WS_H); Bt = (const bf16*)(ws + WS_WDN); N = 1024; K = DFF; break;
            }
            if (mode == 0) { LAS float* gbl = (LAS float*)((LAS unsigned char*)lds + LH_GB); for (int i = tid; i < 2048; i += NWAVES * 64) gbl[i] = P.gate_b[i] * NLOG2E; __syncthreads(); }
            pg8::Gemm g{A, Bt, NTOK, N, K}; pg8::StaticOrder S; S.init(NTOK, N, G, bx);
            Epi E{mode, kp, (PG8_LAS unsigned char*)lds};
            pg8::gemm_phase<Epi, pg8::StaticOrder, true, true>((PG8_LAS unsigned char*)lds, g, S, E, tid);
        }
        if (s + 1 < s_hi) {
            const bool nosync = (s == 2 || s == 6);
            if (nosync) __syncthreads();
            else if (s_hi > 12) grid.sync();
            else { XcdBarrier xb; xb.bar = (unsigned*)(P.ws + WS_CTL); xb.x = xb_xcc_id(); xb.st = xb_st; xcd_barrier(xb); }
        }
    }
#undef P
#undef LANE_ID
}

#ifndef N_SPLIT
#define N_SPLIT 0
#endif
extern "C" void kernel_launch(void* const* d_in, const int* in_sizes, int n_in, void* d_out, int out_size, void* d_ws, size_t ws_size, hipStream_t stream) {
    static int grid = 0;
    if (grid == 0) {
        if (n_in != 19 || in_sizes[0] != NTOK * 1024 || out_size != NTOK * 1024 || ws_size < WS_END) { fprintf(stderr, "kernel_launch: unexpected shapes (n_in %d, ws %zu)\n", n_in, ws_size); grid = -1; return; }
        int dev = 0, cus = 0, per_cu = 0;
        hipGetDevice(&dev); hipDeviceGetAttribute(&cus, hipDeviceAttributeMultiprocessorCount, dev);
        if (hipFuncSetAttribute((const void*)mega_fwd, hipFuncAttributeMaxDynamicSharedMemorySize, LDS_BYTES) != hipSuccess) { fprintf(stderr, "kernel_launch: hipFuncSetAttribute failed\n"); grid = -1; return; }
        hipOccupancyMaxActiveBlocksPerMultiprocessor(&per_cu, (const void*)mega_fwd, NWAVES * 64, LDS_BYTES);
        (void)hipGetLastError();
        if (per_cu < 1 || cus < 256) fprintf(stderr, "kernel_launch: note: occupancy %d per CU, %d CUs\n", per_cu, cus);
        grid = 256;
    }
    if (grid < 0) return;
    Params p{};
    p.x = (const float*)d_in[0]; p.pos = (const int*)d_in[1]; p.w_in = (const float*)d_in[2]; p.gate_b = (const float*)d_in[3]; p.diff_lambda = (const float*)d_in[4]; p.subln_g = (const float*)d_in[5];
    p.qn_g = (const float*)d_in[6]; p.w_uq = (const float*)d_in[7]; p.kvn_g = (const float*)d_in[8]; p.w_ukv = (const float*)d_in[9]; p.w_od = (const float*)d_in[10]; p.w_om = (const float*)d_in[11];
    p.w_out = (const float*)d_in[12]; p.ln1_g = (const float*)d_in[13]; p.ln1_b = (const float*)d_in[14]; p.w_up = (const float*)d_in[15]; p.w_dn = (const float*)d_in[16]; p.ln2_g = (const float*)d_in[17]; p.ln2_b = (const float*)d_in[18];
    p.out = (float*)d_out; p.ws = (unsigned char*)d_ws;
    for (int j = 0; j < 8; ++j) p.invf[j] = (float)pow(500000.0, -(double)j / 8.0);
    for (int j = 0; j < 16; ++j) p.invf[8 + j] = (float)pow(500000.0, -(double)j / 16.0);
#if N_SPLIT
    const int cuts[11] = {0, 1, 2, 4, 5, 7, 8, 9, 10, 11, 12};
    for (int i = 0; i < 10; ++i) { p.s_lo = cuts[i]; p.s_hi = cuts[i + 1];
        hipLaunchKernelGGL(mega_fwd, dim3(grid), dim3(NWAVES * 64), LDS_BYTES, stream, p);
        const hipError_t le = hipPeekAtLastError(); if (le != hipSuccess) { fprintf(stderr, "kernel_launch: launch %d failed: %s\n", i, hipGetErrorName(le)); break; } }
#else
    p.s_lo = 0; p.s_hi = 12;
    if (hipMemsetAsync((char*)d_ws + WS_CTL, 0, CTL_BYTES, stream) != hipSuccess) { fprintf(stderr, "kernel_launch: hipMemsetAsync failed\n"); return; }
    void* args[] = {&p};
    const hipError_t e = hipLaunchCooperativeKernel((const void*)mega_fwd, dim3(grid), dim3(NWAVES * 64), args, LDS_BYTES, stream);
    if (e != hipSuccess) fprintf(stderr, "kernel_launch: cooperative launch failed: %s (grid %d)\n", hipGetErrorString(e), grid);
#endif
}
```

```cpp
#include <hip/hip_runtime.h>
#include <hip/hip_cooperative_groups.h>
#include <hip/hip_bf16.h>
#include <cstdio>
#include <cstdint>
#include <cmath>
namespace cg = cooperative_groups;
namespace pg8 {
#define PG8_LAS __attribute__((address_space(3)))
typedef unsigned short bf16_t;
typedef short bf16x8 __attribute__((ext_vector_type(8)));
typedef float f32x4 __attribute__((ext_vector_type(4)));
typedef unsigned u32x4 __attribute__((ext_vector_type(4)));
constexpr int BM = 256, BK = 64, HALF = 128, HTB = HALF * BK * 2  , STAGE_BYTES = 8 * HTB, NXCD = 8, WGM = 8;

__host__ __device__ __forceinline__ int lds_byte(int r, int c) { const int st = (r >> 4) * 2 + (c >> 5), rr = r & 15, cc = c & 31, ob = rr * 64 + cc * 2; return st * 1024 + (ob ^ (((ob >> 9) & 1) << 5)); }
__host__ __device__ __forceinline__ void stage_rc(int b, int& R, int& C) { const int st = b / 1024, sb = b % 1024, swz = sb ^ (((sb >> 9) & 1) << 5); R = (st >> 1) * 16 + swz / 64; C = (st & 1) * 32 + (swz % 64) / 2; }
__host__ __device__ __forceinline__ int perm32(int rho) { const int n = rho >> 4, i = rho & 15; return 8 * (i >> 2) + 4 * n + (i & 3); }

struct Unit { int pm, pn; };
struct Gemm { const bf16_t* A; const bf16_t* Bt; int M, N, K; };

struct StaticOrder {
    int nM, nN, nwg, G, c;
    __host__ __device__ void init(int M, int N, int G_, int c_) { nM = M / BM; nN = N / BM; nwg = nM * nN; G = G_; c = c_; }
    __host__ __device__ bool next(int i, Unit& u) const {
        const long L = (long)i * G + c; if (L >= nwg) return false;
        int wgid = (int)L; { const int q = nwg / NXCD, r = nwg % NXCD, xcd = wgid % NXCD, off = wgid / NXCD; wgid = (xcd < r ? xcd * (q + 1) : r * (q + 1) + (xcd - r) * q) + off; }
        const int nig = WGM * nN, gid = wgid / nig, fm = gid * WGM, gsz = (nM - fm) < WGM ? (nM - fm) : WGM;
        u.pm = fm + ((wgid % nig) % gsz); u.pn = (wgid % nig) / gsz; return true;
    }
    __device__ __forceinline__ void a_ready(const Unit&) const {}
    __device__ __forceinline__ void done(const Unit&) const {}
};

typedef float f32x2c __attribute__((ext_vector_type(2))); typedef __bf16 bf16x2c __attribute__((ext_vector_type(2)));
__device__ __forceinline__ unsigned cvt_pk_bf16(float lo, float hi) { f32x2c v = {lo, hi}; bf16x2c b = __builtin_convertvector(v, bf16x2c); return __builtin_bit_cast(unsigned, b); }
typedef float f32x2 __attribute__((ext_vector_type(2)));
template <class Epi, class Sched, bool ALIGN_EPI = false, bool SP2 = false>
__device__ __forceinline__ void gemm_phase(PG8_LAS unsigned char* lds, const Gemm g, const Sched& S, const Epi& E, const int tid_in) {
    const int tid = tid_in, wid = __builtin_amdgcn_readfirstlane(tid >> 6), lane = tid & 63, wr = wid >> 2, wc = wid & 3, fr = lane & 15, fq = lane >> 4;
    const int K = g.K, nt = K / BK;
    unsigned voffA[2], voffB[2];
#pragma unroll
    for (int i = 0; i < 2; ++i) { int R, C; stage_rc(tid * 16 + i * 8192, R, C); const int Rb = Epi::PERM ? ((R & ~31) + perm32(R & 31)) : R;
        voffA[i] = (unsigned)(R * K + C) * 2u; voffB[i] = (unsigned)(Rb * K + C) * 2u; }
    const size_t kstep = (size_t)(BK * 2);
    const size_t hstep = (size_t)HALF * K * 2;
    const size_t tstep = 2 * hstep;
    const unsigned ldsw = (unsigned)wid * 1024u;
    const int aoff = lds_byte(wr * 64 + fr, fq * 8), boff = lds_byte(wc * 32 + fr, fq * 8);
#define PG8_SA(b, h) (((b) * 2 + (h)) * HTB)
#define PG8_SB(b, h) ((4 + (b) * 2 + (h)) * HTB)
#define PG8_STAGE(bufoff, gbase, voff) do { _Pragma("unroll") for (int _i = 0; _i < 2; ++_i) \
        __builtin_amdgcn_global_load_lds((const unsigned*)((const char*)(gbase) + (voff)[_i]), (PG8_LAS unsigned*)(lds + (bufoff) + ldsw + _i * 8192), 16, 0, 0); } while (0)
#define PG8_LDA(dst, b, h) do { _Pragma("unroll") for (int m = 0; m < 4; ++m) _Pragma("unroll") for (int k = 0; k < 2; ++k) dst[m][k] = *(const PG8_LAS bf16x8*)(lds + PG8_SA(b, h) + aoff + m * 2048 + k * 1024); } while (0)
#define PG8_LDB(dst, b, h) do { _Pragma("unroll") for (int n = 0; n < 2; ++n) _Pragma("unroll") for (int k = 0; k < 2; ++k) dst[n][k] = *(const PG8_LAS bf16x8*)(lds + PG8_SB(b, h) + boff + n * 2048 + k * 1024); } while (0)
#define PG8_MMA(ai, bj, At, Bt) do { __builtin_amdgcn_s_setprio(1); _Pragma("unroll") for (int m = 0; m < 4; ++m) _Pragma("unroll") for (int n = 0; n < 2; ++n) _Pragma("unroll") for (int k = 0; k < 2; ++k) \
        acc[ai][bj][m][n] = __builtin_amdgcn_mfma_f32_16x16x32_bf16(Bt[n][k], At[m][k], acc[ai][bj][m][n], 0, 0, 0); __builtin_amdgcn_s_setprio(0); } while (0)
#define PG8_WAIT_V(n) asm volatile("s_waitcnt vmcnt(" #n ")" ::: "memory")
#define PG8_WAIT_L(n) asm volatile("s_waitcnt lgkmcnt(" #n ")" ::: "memory")
#define PG8_BAR __builtin_amdgcn_s_barrier()
#define PG8_SCHED __builtin_amdgcn_sched_barrier(0)
    Unit cur, nxt; int ui = 0;
    if (!S.next(0, cur)) return;
    f32x4 acc[2][2][4][2];
#pragma unroll
    for (int a = 0; a < 2; ++a)
#pragma unroll
        for (int b = 0; b < 2; ++b)
#pragma unroll
            for (int m = 0; m < 4; ++m)
#pragma unroll
                for (int n = 0; n < 2; ++n) { float z_ = 0.f; asm volatile("" : "+v"(z_)); acc[a][b][m][n] = (f32x4){z_, z_, z_, z_}; }
    E.init(acc, cur, wr, wc, fq);
    bf16x8 At[4][2], B0[2][2], B1[2][2];
    const char* cA = (const char*)g.A + (size_t)cur.pm * tstep; const char* cB = (const char*)g.Bt + (size_t)cur.pn * tstep;
    S.a_ready(cur);
    if constexpr (SP2) {
        PG8_STAGE(PG8_SB(0, 0), cB, voffB); PG8_STAGE(PG8_SB(0, 1), cB + hstep, voffB); PG8_STAGE(PG8_SA(0, 0), cA, voffA); PG8_STAGE(PG8_SA(0, 1), cA + hstep, voffA);
        if (wr == 1) PG8_BAR;
        PG8_WAIT_V(2); PG8_BAR;
        PG8_STAGE(PG8_SB(1, 0), cB + kstep, voffB); PG8_STAGE(PG8_SA(1, 0), cA + kstep, voffA); PG8_STAGE(PG8_SB(1, 1), cB + hstep + kstep, voffB);
        PG8_WAIT_V(6); PG8_BAR;
    } else {
        PG8_STAGE(PG8_SB(0, 0), cB, voffB); PG8_STAGE(PG8_SA(0, 0), cA, voffA); PG8_STAGE(PG8_SB(0, 1), cB + hstep, voffB); PG8_STAGE(PG8_SA(0, 1), cA + hstep, voffA);
        if (wr == 1) PG8_BAR;
        PG8_WAIT_V(4); PG8_BAR;
        PG8_STAGE(PG8_SB(1, 0), cB + kstep, voffB); PG8_STAGE(PG8_SA(1, 0), cA + kstep, voffA); PG8_STAGE(PG8_SB(1, 1), cB + hstep + kstep, voffB);
        PG8_WAIT_V(6); PG8_BAR;
    }
    for (;;) {
        const bool has_next = S.next(ui + 1, nxt);
        const char* nA = has_next ? (const char*)g.A + (size_t)nxt.pm * tstep : cA; const char* nB = has_next ? (const char*)g.Bt + (size_t)nxt.pn * tstep : cB;
        for (int t = 0; t < nt; t += 2) {
            if (E.mode == 3 && t == (nt >> 1)) E.mid(acc, cur, wr, wc, fr, fq);
            const bool last = (t == nt - 2);
            const char* a1 = cA + (size_t)(t + 1) * kstep;
            const char* a2 = last ? nA : cA + (size_t)(t + 2) * kstep; const char* b2 = last ? nB : cB + (size_t)(t + 2) * kstep;
            const char* a3 = a2 + kstep; const char* b3 = b2 + kstep;
            if (last && has_next) S.a_ready(nxt);
            if constexpr (SP2) {
            PG8_LDB(B0, 0, 0); PG8_LDB(B1, 0, 1); PG8_SCHED; PG8_LDA(At, 0, 0); PG8_STAGE(PG8_SA(1, 1), a1 + hstep, voffA);
            PG8_WAIT_V(8); PG8_WAIT_L(0); PG8_BAR; PG8_MMA(0, 0, At, B0); PG8_MMA(0, 1, At, B1); PG8_BAR; PG8_SCHED;
            PG8_LDA(At, 0, 1); PG8_STAGE(PG8_SB(0, 0), b2, voffB); PG8_STAGE(PG8_SB(0, 1), b2 + hstep, voffB); PG8_STAGE(PG8_SA(0, 0), a2, voffA);
            PG8_WAIT_V(8); PG8_WAIT_L(0); PG8_BAR; PG8_MMA(1, 0, At, B0); PG8_MMA(1, 1, At, B1); PG8_BAR; PG8_SCHED;
            PG8_LDB(B0, 1, 0); PG8_LDB(B1, 1, 1); PG8_SCHED; PG8_LDA(At, 1, 0); PG8_STAGE(PG8_SA(0, 1), a2 + hstep, voffA);
            PG8_WAIT_V(8); PG8_WAIT_L(0); PG8_BAR; PG8_MMA(0, 0, At, B0); PG8_MMA(0, 1, At, B1); PG8_BAR; PG8_SCHED;
            PG8_LDA(At, 1, 1); PG8_STAGE(PG8_SB(1, 0), b3, voffB); PG8_STAGE(PG8_SB(1, 1), b3 + hstep, voffB); PG8_STAGE(PG8_SA(1, 0), a3, voffA);
            PG8_WAIT_V(8); PG8_WAIT_L(0); PG8_BAR; PG8_MMA(1, 0, At, B0); PG8_MMA(1, 1, At, B1); PG8_BAR; PG8_SCHED;
            } else {
            PG8_LDB(B0, 0, 0); PG8_SCHED; PG8_LDA(At, 0, 0); PG8_STAGE(PG8_SA(1, 1), a1 + hstep, voffA);
            PG8_WAIT_L(8); PG8_BAR; PG8_WAIT_L(0); PG8_MMA(0, 0, At, B0); PG8_BAR; PG8_SCHED;
            PG8_LDB(B1, 0, 1); PG8_STAGE(PG8_SB(0, 0), b2, voffB);
            PG8_BAR; PG8_WAIT_L(0); PG8_MMA(0, 1, At, B1); PG8_BAR;
            PG8_LDA(At, 0, 1); PG8_STAGE(PG8_SA(0, 0), a2, voffA);
            PG8_BAR; PG8_WAIT_L(0); PG8_MMA(1, 0, At, B0); PG8_BAR; PG8_SCHED;
            PG8_STAGE(PG8_SB(0, 1), b2 + hstep, voffB);
            PG8_WAIT_V(6); PG8_BAR; PG8_MMA(1, 1, At, B1); PG8_BAR;
            PG8_LDB(B0, 1, 0); PG8_SCHED; PG8_LDA(At, 1, 0); PG8_STAGE(PG8_SA(0, 1), a2 + hstep, voffA);
            PG8_WAIT_L(8); PG8_BAR; PG8_WAIT_L(0); PG8_MMA(0, 0, At, B0); PG8_BAR; PG8_SCHED;
            PG8_LDB(B1, 1, 1); PG8_STAGE(PG8_SB(1, 0), b3, voffB);
            PG8_BAR; PG8_WAIT_L(0); PG8_MMA(0, 1, At, B1); PG8_BAR;
            PG8_LDA(At, 1, 1); PG8_STAGE(PG8_SA(1, 0), a3, voffA);
            PG8_BAR; PG8_WAIT_L(0); PG8_MMA(1, 0, At, B0); PG8_BAR; PG8_SCHED;
            PG8_STAGE(PG8_SB(1, 1), b3 + hstep, voffB);
            PG8_WAIT_V(6); PG8_BAR; PG8_MMA(1, 1, At, B1); PG8_BAR;
            }
        }
        if constexpr (ALIGN_EPI) { if (wr == 0) PG8_BAR; }
        if constexpr (!Epi::AFTER_DRAIN) { E(acc, cur, wr, wc, fr, fq); S.done(cur); }
        if (!has_next) break;
#pragma unroll
        for (int a = 0; a < 2; ++a)
#pragma unroll
            for (int b = 0; b < 2; ++b)
#pragma unroll
                for (int m = 0; m < 4; ++m)
#pragma unroll
                    for (int n = 0; n < 2; ++n) { float z_ = 0.f; asm volatile("" : "+v"(z_)); acc[a][b][m][n] = (f32x4){z_, z_, z_, z_}; }
        E.init(acc, nxt, wr, wc, fq);
        cur = nxt; cA = nA; cB = nB; ++ui;
        if constexpr (ALIGN_EPI) { if (wr == 1) PG8_BAR; }
    }
    PG8_WAIT_V(0);
    if constexpr (!ALIGN_EPI) { if (wr == 0) PG8_BAR; }
    PG8_BAR;
    if constexpr (Epi::AFTER_DRAIN) { E.fused(acc, cur, wr, wc, fr, fq, lds, wid, lane); S.done(cur); }
#undef PG8_SA
#undef PG8_SB
#undef PG8_STAGE
#undef PG8_LDA
#undef PG8_LDB
#undef PG8_MMA
#undef PG8_WAIT_V
#undef PG8_WAIT_L
#undef PG8_BAR
#undef PG8_SCHED
}
}

#define GAS __attribute__((address_space(1)))
#define LAS __attribute__((address_space(3)))
typedef unsigned short bf16;
typedef unsigned v4u __attribute__((ext_vector_type(4)));
typedef float f32x4 __attribute__((ext_vector_type(4)));
typedef short bf16x8 __attribute__((ext_vector_type(8)));
typedef short s16x4 __attribute__((ext_vector_type(4)));
typedef float f32x16 __attribute__((ext_vector_type(16)));

constexpr int NWAVES = 8;
constexpr int NB = 16, SEQ = 4096, NTOK = NB * SEQ, DMODEL = 1024, DIN = 4256, DINP = 4352, DFF = 4096;
constexpr float LOG2E = 1.4426950408889634f;
constexpr float C2D = 0.125f * LOG2E;
constexpr float C2M = 0.10206207261596577f * LOG2E;
constexpr float ALPHA = 1.189207115002721f;
constexpr float LN_EPS = 1e-5f, RMS_EPS = 1e-6f;
constexpr float NLOG2E = -1.4426950408889634f;
constexpr int LH_GB = 131072 + 1024;
constexpr float LAMBDA_INIT = 0.2f;

constexpr size_t MiB = 1u << 20;
constexpr size_t WS_XB = 0, WS_DQ = 128 * MiB, WS_DK = 192 * MiB, WS_DV = 256 * MiB, WS_CQ = 320 * MiB, WS_CKV = 368 * MiB, WS_KR = 400 * MiB,
                 WS_G = 404 * MiB, WS_QM = 660 * MiB, WS_KV = 756 * MiB;
constexpr size_t WS_OD = 0, WS_OM = 64 * MiB, WS_Y = 128 * MiB, WS_X1 = 0, WS_X1B = 256 * MiB, WS_H = 384 * MiB;
constexpr size_t WS_WIN = 900 * MiB, WS_WUQ = 909 * MiB, WS_WUKV = 910 * MiB, WS_WOD = 911 * MiB, WS_WOM = 912 * MiB, WS_WOUT = 913 * MiB,
                 WS_WUP = 915 * MiB, WS_WDN = 923 * MiB, WS_TD = 931 * MiB, WS_TM = 935 * MiB, WS_SSQ = 943 * MiB, WS_O1 = 948 * MiB, WS_END = 980 * MiB;
constexpr size_t WS_CTL = 896 * MiB, CTL_BYTES = 16384;

constexpr int RING_BYTES = 131072, LDS_BYTES = 147456;

struct Params {
    const float* x; const int* pos; const float* w_in; const float* gate_b; const float* diff_lambda; const float* subln_g; const float* qn_g; const float* w_uq;
    const float* kvn_g; const float* w_ukv; const float* w_od; const float* w_om; const float* w_out; const float* ln1_g; const float* ln1_b; const float* w_up; const float* w_dn;
    const float* ln2_g; const float* ln2_b;
    float* out; unsigned char* ws; float invf[24]; int s_lo, s_hi;
};

__device__ __forceinline__ unsigned f2bf(float f) { unsigned u = __builtin_bit_cast(unsigned, f); return (u + 0x7fffu + ((u >> 16) & 1u)) >> 16; }
__device__ __forceinline__ unsigned pk2(float lo, float hi) { return f2bf(lo) | (f2bf(hi) << 16); }
__device__ __forceinline__ float bf2f(unsigned short h) { return __builtin_bit_cast(float, (unsigned)h << 16); }
__device__ __forceinline__ float shxl(float v, int m, int lane) { return __builtin_bit_cast(float, __builtin_amdgcn_ds_bpermute((lane ^ m) << 2, __builtin_bit_cast(int, v))); }
__device__ __forceinline__ float wave_sum(float v, int lane) {
#pragma unroll
    for (int o = 1; o < 64; o <<= 1) v += shxl(v, o, lane);
    return v;
}

struct Epi {
    static constexpr bool PERM = true, AFTER_DRAIN = false;
    int mode; const __attribute__((address_space(4))) Params* kp; PG8_LAS unsigned char* lds;
    __device__ __forceinline__ static void st8_nt(bf16* p, pg8::f32x4 v0, pg8::f32x4 v1) {
        pg8::u32x4 w; w.x = pg8::cvt_pk_bf16(v0[0], v0[1]); w.y = pg8::cvt_pk_bf16(v0[2], v0[3]); w.z = pg8::cvt_pk_bf16(v1[0], v1[1]); w.w = pg8::cvt_pk_bf16(v1[2], v1[3]);
        __builtin_nontemporal_store(w, (pg8::u32x4*)p);
    }
    __device__ __forceinline__ static void st8(bf16* p, pg8::f32x4 v0, pg8::f32x4 v1) {
        pg8::u32x4 w; w.x = pg8::cvt_pk_bf16(v0[0], v0[1]); w.y = pg8::cvt_pk_bf16(v0[2], v0[3]); w.z = pg8::cvt_pk_bf16(v1[0], v1[1]); w.w = pg8::cvt_pk_bf16(v1[2], v1[3]);
        *(pg8::u32x4*)p = w;
    }
    __device__ __forceinline__ static void ld8(const bf16* p, pg8::f32x4& v0, pg8::f32x4& v1) {
        const pg8::u32x4 w = *(const pg8::u32x4*)p;
        v0[0] = __builtin_bit_cast(float, w.x << 16); v0[1] = __builtin_bit_cast(float, w.x & 0xffff0000u); v0[2] = __builtin_bit_cast(float, w.y << 16); v0[3] = __builtin_bit_cast(float, w.y & 0xffff0000u);
        v1[0] = __builtin_bit_cast(float, w.z << 16); v1[1] = __builtin_bit_cast(float, w.z & 0xffff0000u); v1[2] = __builtin_bit_cast(float, w.w << 16); v1[3] = __builtin_bit_cast(float, w.w & 0xffff0000u);
    }
    __device__ __forceinline__ static float px(float v, int m, int lane) {
        const unsigned u = __builtin_bit_cast(unsigned, v);
        if (m == 32) { auto rr = __builtin_amdgcn_permlane32_swap(u, u, false, false); return __builtin_bit_cast(float, (lane & 32) ? (unsigned)rr[0] : (unsigned)rr[1]); }
        else { auto rr = __builtin_amdgcn_permlane16_swap(u, u, false, false); return __builtin_bit_cast(float, (lane & 16) ? (unsigned)rr[0] : (unsigned)rr[1]); }
    }
    __device__ __forceinline__ static pg8::f32x4 shx(pg8::f32x4 v, int m, int lane) { pg8::f32x4 r; r[0] = px(v[0], m, lane); r[1] = px(v[1], m, lane); r[2] = px(v[2], m, lane); r[3] = px(v[3], m, lane); return r; }
    __device__ __forceinline__ static void rope32(pg8::f32x4& v0, pg8::f32x4& v1, const float* trow, int fq, int lane) {
        const pg8::f32x4 q0 = shx(v0, 32, lane), q1 = shx(v1, 32, lane);
        const int i0 = 8 * (fq & 1); const float sg = fq < 2 ? -1.f : 1.f;
        const pg8::f32x4 c0 = *(const pg8::f32x4*)(trow + i0), c1 = *(const pg8::f32x4*)(trow + i0 + 4), s0 = *(const pg8::f32x4*)(trow + 16 + i0), s1 = *(const pg8::f32x4*)(trow + 16 + i0 + 4);
        v0 = v0 * c0 + (q0 * s0) * sg; v1 = v1 * c1 + (q1 * s1) * sg;
    }
    __device__ __forceinline__ void mid(pg8::f32x4 (&acc)[2][2][4][2], const pg8::Unit& u, int wr_, int wc_, int fr_, int fq_) const {
        using pg8::f32x4; using pg8::BM; using pg8::HALF;
        int wr = wr_, wc = wc_, fr = fr_, fq = fq_; asm volatile("" : "+s"(wr), "+s"(wc), "+v"(fr), "+v"(fq));
        unsigned char* const ws = kp->ws; const bf16* const G = (const bf16*)(ws + WS_G);
        const int row0 = u.pm * BM + wr * 64 + fr;
#pragma unroll
        for (int bj = 0; bj < 2; ++bj) { const int c0 = u.pn * BM + bj * HALF + wc * 32 + 8 * fq;
#pragma unroll
            for (int ai = 0; ai < 2; ++ai)
#pragma unroll
                for (int m = 0; m < 4; ++m) { const int row = row0 + ai * HALF + m * 16; f32x4 g0a, g0b, g1a, g1b;
                    ld8(G + (size_t)row * 2048 + c0, g0a, g0b); ld8(G + (size_t)row * 2048 + 1024 + c0, g1a, g1b);
#pragma unroll
                    for (int j = 0; j < 4; ++j) { acc[ai][bj][m][0][j] *= g0a[j] * __builtin_amdgcn_rcpf(g1a[j]); acc[ai][bj][m][1][j] *= g0b[j] * __builtin_amdgcn_rcpf(g1b[j]); } } }
    }
    __device__ __forceinline__ void init(pg8::f32x4 (&acc)[2][2][4][2], const pg8::Unit& u, int wr, int wc, int fq) const {
        if (mode != 0) return;
#pragma unroll
        for (int bj = 0; bj < 2; ++bj) { const int c32 = u.pn * pg8::BM + bj * pg8::HALF + wc * 32;
            if (c32 >= 2208 && c32 < DIN) { const PG8_LAS float* gb = (const PG8_LAS float*)(lds + LH_GB) + (c32 - 2208) + 8 * fq;
                const pg8::f32x4 b0 = *(const PG8_LAS pg8::f32x4*)gb, b1 = *(const PG8_LAS pg8::f32x4*)(gb + 4);
#pragma unroll
                for (int ai = 0; ai < 2; ++ai)
#pragma unroll
                    for (int m = 0; m < 4; ++m) { acc[ai][bj][m][0] = b0; acc[ai][bj][m][1] = b1; } } }
    }
    __device__ __forceinline__ void operator()(const pg8::f32x4 (&acc)[2][2][4][2], const pg8::Unit& u, int wr_, int wc_, int fr_, int fq_) const {
        using pg8::f32x4; using pg8::BM; using pg8::HALF;
        int wr = wr_, wc = wc_, fr = fr_, fq = fq_; asm volatile("" : "+s"(wr), "+s"(wc), "+v"(fr), "+v"(fq));
        const int row0 = u.pm * BM + wr * 64 + fr, lane = fq * 16 + fr;
        unsigned char* const ws = kp->ws;
        bf16* const DQ = (bf16*)(ws + WS_DQ); bf16* const DK = (bf16*)(ws + WS_DK); bf16* const DV = (bf16*)(ws + WS_DV); bf16* const CQ = (bf16*)(ws + WS_CQ);
        bf16* const CKV = (bf16*)(ws + WS_CKV); bf16* const KR = (bf16*)(ws + WS_KR); bf16* const G = (bf16*)(ws + WS_G); bf16* const QM = (bf16*)(ws + WS_QM); bf16* const KV = (bf16*)(ws + WS_KV);
        bf16* const Y = (bf16*)(ws + WS_Y); bf16* const H = (bf16*)(ws + WS_H);
        float* const SSQ = (float*)(ws + WS_SSQ); const float* const TD = (const float*)(ws + WS_TD); const float* const TM = (const float*)(ws + WS_TM);
        if (mode == 0) {
#pragma unroll
            for (int bj = 0; bj < 2; ++bj) {
                const int c32 = u.pn * BM + bj * HALF + wc * 32, c0 = c32 + 8 * fq;
                if (c32 < 1024) {
                    bf16* dst = (c32 < 512) ? DQ : DK; const float sc = (c32 < 512) ? C2D : 1.f; const int cc = c0 & 511; const bool rope = (c32 & 32) == 0;
#pragma unroll
                    for (int ai = 0; ai < 2; ++ai)
#pragma unroll
                        for (int m = 0; m < 4; ++m) { const int row = row0 + ai * HALF + m * 16; f32x4 v0 = acc[ai][bj][m][0], v1 = acc[ai][bj][m][1];
                            if (rope) { const f32x4 q0 = shx(v0, 16, lane), q1 = shx(v1, 16, lane);
                                if (fq < 2) { const float* t = TD + (size_t)row * 16; const float sg = fq == 0 ? -1.f : 1.f;
                                    const f32x4 cs0 = *(const f32x4*)(t), cs1 = *(const f32x4*)(t + 4), sn0 = *(const f32x4*)(t + 8), sn1 = *(const f32x4*)(t + 12);
                                    v0 = v0 * cs0 + (q0 * sn0) * sg; v1 = v1 * cs1 + (q1 * sn1) * sg; } }
                            st8_nt(dst + (size_t)row * 512 + cc, v0 * sc, v1 * sc); }
                } else if (c32 < 1536) {
#pragma unroll
                    for (int ai = 0; ai < 2; ++ai)
#pragma unroll
                        for (int m = 0; m < 4; ++m) { const int row = row0 + ai * HALF + m * 16; st8_nt(DV + (size_t)row * 512 + (c0 - 1024), acc[ai][bj][m][0], acc[ai][bj][m][1]); }
                } else if (c32 < 2176) {
                    const bool isq = c32 < 1920; bf16* dst = isq ? CQ : CKV; const int pitch = isq ? 384 : 256, cc = isq ? c0 - 1536 : c0 - 1920, slot = isq ? (c32 - 1536) / 32 : 12 + (c32 - 1920) / 32;
#pragma unroll
                    for (int ai = 0; ai < 2; ++ai)
#pragma unroll
                        for (int m = 0; m < 4; ++m) { const int row = row0 + ai * HALF + m * 16; const f32x4 v0 = acc[ai][bj][m][0], v1 = acc[ai][bj][m][1];
                            float s = (v0[0] * v0[0] + v0[1] * v0[1]) + (v0[2] * v0[2] + v0[3] * v0[3]) + (v1[0] * v1[0] + v1[1] * v1[1]) + (v1[2] * v1[2] + v1[3] * v1[3]);
                            s += px(s, 16, lane); s += px(s, 32, lane);
                            if (fq == 0) SSQ[(size_t)row * 20 + slot] = s;
                            st8(dst + (size_t)row * pitch + cc, v0, v1); }
                } else if (c32 < 2208) {
#pragma unroll
                    for (int ai = 0; ai < 2; ++ai)
#pragma unroll
                        for (int m = 0; m < 4; ++m) { const int row = row0 + ai * HALF + m * 16; f32x4 v0 = acc[ai][bj][m][0], v1 = acc[ai][bj][m][1];
                            rope32(v0, v1, TM + (size_t)row * 32, fq, lane); st8(KR + (size_t)row * 32 + 8 * fq, v0, v1); }
                } else if (c32 < DIN) {
                    const int gc = c0 - 2208;
#pragma unroll
                    for (int ai = 0; ai < 2; ++ai)
#pragma unroll
                        for (int m = 0; m < 4; ++m) { const int row = row0 + ai * HALF + m * 16; f32x4 v0 = acc[ai][bj][m][0], v1 = acc[ai][bj][m][1];
#pragma unroll
                            for (int j = 0; j < 4; ++j) { v0[j] = __builtin_amdgcn_rcpf(1.f + __builtin_amdgcn_exp2f(v0[j])); v1[j] = __builtin_amdgcn_rcpf(1.f + __builtin_amdgcn_exp2f(v1[j])); }
                            st8_nt(G + (size_t)row * 2048 + gc, v0, v1); }
                }
            }
        } else if (mode == 1 || mode == 2) {
            float rs[2][4];
#pragma unroll
            for (int ai = 0; ai < 2; ++ai)
#pragma unroll
                for (int m = 0; m < 4; ++m) { const float* sp = SSQ + (size_t)(row0 + ai * HALF + m * 16) * 20;
                    if (mode == 1) { const f32x4 a = *(const f32x4*)(sp), b = *(const f32x4*)(sp + 4), c = *(const f32x4*)(sp + 8);
                        const float t = ((a[0] + a[1]) + (a[2] + a[3])) + ((b[0] + b[1]) + (b[2] + b[3])) + ((c[0] + c[1]) + (c[2] + c[3])); rs[ai][m] = 1.0f / sqrtf(t * (1.f / 384.f) + RMS_EPS); }
                    else { const f32x4 a = *(const f32x4*)(sp + 12), b = *(const f32x4*)(sp + 16);
                        const float t = ((a[0] + a[1]) + (a[2] + a[3])) + ((b[0] + b[1]) + (b[2] + b[3])); rs[ai][m] = 1.0f / sqrtf(t * (1.f / 256.f) + RMS_EPS); } }
#pragma unroll
            for (int bj = 0; bj < 2; ++bj) {
                const int c32 = u.pn * BM + bj * HALF + wc * 32, c0 = c32 + 8 * fq; const bool rope = (mode == 1) && ((c32 >> 5) % 3 == 2);
#pragma unroll
                for (int ai = 0; ai < 2; ++ai)
#pragma unroll
                    for (int m = 0; m < 4; ++m) { const int row = row0 + ai * HALF + m * 16; f32x4 v0 = acc[ai][bj][m][0] * rs[ai][m], v1 = acc[ai][bj][m][1] * rs[ai][m];
                        if (mode == 1) { if (rope) rope32(v0, v1, TM + (size_t)row * 32, fq, lane); st8_nt(QM + (size_t)row * 768 + c0, v0 * C2M, v1 * C2M); }
                        else st8_nt(KV + (size_t)row * 1024 + c0, v0, v1); }
            }
        } else if (mode == 7) {
            bf16* const X1B = (bf16*)(ws + WS_X1B);
#pragma unroll
            for (int bj = 0; bj < 2; ++bj) { const int c0 = u.pn * BM + bj * HALF + wc * 32 + 8 * fq;
#pragma unroll
                for (int ai = 0; ai < 2; ++ai)
#pragma unroll
                    for (int m = 0; m < 4; ++m) { const int row = row0 + ai * HALF + m * 16; bf16* p = X1B + (size_t)row * 1024 + c0; f32x4 x0, x1;
                        ld8(p, x0, x1); st8(p, x0 * ALPHA + acc[ai][bj][m][0], x1 * ALPHA + acc[ai][bj][m][1]); } }
        } else {
            float* const out = kp->out; const float* const x = kp->x;
#pragma unroll
            for (int bj = 0; bj < 2; ++bj) {
                const int c0 = u.pn * BM + bj * HALF + wc * 32 + 8 * fq;
#pragma unroll
                for (int ai = 0; ai < 2; ++ai)
#pragma unroll
                    for (int m = 0; m < 4; ++m) { const int row = row0 + ai * HALF + m * 16; const f32x4 a0 = acc[ai][bj][m][0], a1 = acc[ai][bj][m][1];
                        float* o = out + (size_t)row * 1024 + c0;
                        if (mode == 3) { f32x4 g0, g1; ld8(G + (size_t)row * 2048 + 1024 + c0, g0, g1); st8(Y + (size_t)row * 1024 + c0, a0 * g0, a1 * g1); }
                        else if (mode == 5) { const float* xr = x + (size_t)row * 1024 + c0; st8((bf16*)(ws + WS_X1B) + (size_t)row * 1024 + c0, __builtin_nontemporal_load((const f32x4*)xr) * ALPHA + a0, __builtin_nontemporal_load((const f32x4*)(xr + 4)) * ALPHA + a1); }
                        else if (mode == 6) { f32x4 r0, r1;
#pragma unroll
                            for (int j = 0; j < 4; ++j) { const float t0 = fmaxf(a0[j], 0.f), t1 = fmaxf(a1[j], 0.f); r0[j] = t0 * t0; r1[j] = t1 * t1; }
                            st8_nt(H + (size_t)row * DFF + c0, r0, r1); }
                        else { } }
            }
        }
    }
};

namespace att {
typedef LAS const char* lds_cptr;
typedef float f32x2_t __attribute__((ext_vector_type(2))); typedef __bf16 bf16x2_t __attribute__((ext_vector_type(2)));
__device__ __forceinline__ int crow(int r, int hi) { return (r & 3) + 8 * (r >> 2) + 4 * hi; }
__device__ __forceinline__ unsigned cvtpk_s(float lo, float hi) { f32x2_t v = {lo, hi}; bf16x2_t b = __builtin_convertvector(v, bf16x2_t); return __builtin_bit_cast(unsigned, b); }
__device__ __forceinline__ void glds16(const void* gsrc, unsigned lds_dst) { unsigned keep;
    asm volatile("s_mov_b32 %0, m0\n\ts_mov_b32 m0, %2\n\ts_nop 0\n\tglobal_load_lds_dwordx4 %1, off\n\ts_mov_b32 m0, %0" : "=&s"(keep) : "v"(gsrc), "s"(lds_dst) : "memory"); }
constexpr int L_K = 0, KSLOT = 12288, L_V = 24576, VSLOT = 16384, L_WS = 57344;
struct Src { const bf16* Q; int qp; const bf16* K1; int k1p; const bf16* K2; int k2p; const bf16* V; int vp; };

typedef short v4i16_t __attribute__((ext_vector_type(4)));
__device__ __forceinline__ s16x4 vtr(lds_cptr p) { return __builtin_bit_cast(s16x4, __builtin_amdgcn_ds_read_tr16_b64_v4i16((LAS v4i16_t*)p)); }

template <int DQK>
__device__ __forceinline__ void qk_tile(lds_cptr kb, const bf16x8 (&qr)[DQK / 16], f32x16& p0, f32x16& p1) {
    p0 = f32x16{}; p1 = f32x16{};
#pragma unroll
    for (int d0 = 0; d0 < DQK / 16; ++d0) { const bf16x8 b0 = *(const LAS bf16x8*)(kb + d0 * 2048), b1 = *(const LAS bf16x8*)(kb + d0 * 2048 + 512);
        p0 = __builtin_amdgcn_mfma_f32_32x32x16_bf16(b0, qr[d0], p0, 0, 0, 0); p1 = __builtin_amdgcn_mfma_f32_32x32x16_bf16(b1, qr[d0], p1, 0, 0, 0); }
}

__device__ __forceinline__ float max_halves(float v) { const unsigned u = __builtin_bit_cast(unsigned, v); auto rr = __builtin_amdgcn_permlane32_swap(u, u, false, false);
    return fmaxf(__builtin_bit_cast(float, (unsigned)rr[0]), __builtin_bit_cast(float, (unsigned)rr[1])); }
#define ATT_FENCE() __builtin_amdgcn_sched_barrier(0)

template <int DQK, int DV, bool MASKN, int THR>
__device__ __forceinline__ void attn_step(lds_cptr kb_next, lds_cptr vb, const bf16x8 (&qr)[DQK / 16], f32x16& c0, f32x16& c1, f32x16& n0, f32x16& n1, float& rm,
                                          f32x16& negm, float& mhat, f32x16 (&o)[DV / 32], float& l_run, LAS float* wsf, int t, int qabs, int r32, int hi) {
    constexpr int ND = DQK / 16;
    if (__any(rm > (float)THR)) {
        const float dl = fmaxf(rm, 0.f); mhat += dl;
#pragma unroll
        for (int r = 0; r < 16; ++r) { c0[r] -= dl; c1[r] -= dl; negm[r] = -mhat; }
        const float f = __builtin_amdgcn_exp2f(-dl); l_run *= f;
        if (hi == 0) wsf[r32] = f;
#pragma unroll
        for (int k = 0; k < 4; ++k) { const f32x4 a = *(const LAS f32x4*)(wsf + 8 * k + 4 * hi);
#pragma unroll
            for (int d = 0; d < DV / 32; ++d) { o[d][4 * k] *= a[0]; o[d][4 * k + 1] *= a[1]; o[d][4 * k + 2] *= a[2]; o[d][4 * k + 3] *= a[3]; } }
    }
    bf16x8 b0 = *(const LAS bf16x8*)(kb_next), b1 = *(const LAS bf16x8*)(kb_next + 512);
    ATT_FENCE();
#pragma unroll
    for (int d0 = 0; d0 < ND; ++d0) {
        bf16x8 nb0 = b0, nb1 = b1;
        if (d0 + 1 < ND) { nb0 = *(const LAS bf16x8*)(kb_next + (d0 + 1) * 2048); nb1 = *(const LAS bf16x8*)(kb_next + (d0 + 1) * 2048 + 512); }
        if (d0 == 0) { n0 = __builtin_amdgcn_mfma_f32_32x32x16_bf16(b0, qr[0], negm, 0, 0, 0); n1 = __builtin_amdgcn_mfma_f32_32x32x16_bf16(b1, qr[0], negm, 0, 0, 0); }
        else { n0 = __builtin_amdgcn_mfma_f32_32x32x16_bf16(b0, qr[d0], n0, 0, 0, 0); n1 = __builtin_amdgcn_mfma_f32_32x32x16_bf16(b1, qr[d0], n1, 0, 0, 0); }
#pragma unroll
        for (int e = (8 * d0) / ND; e < (8 * (d0 + 1)) / ND; ++e) c0[e] = __builtin_amdgcn_exp2f(c0[e]);
        ATT_FENCE();
        b0 = nb0; b1 = nb1;
    }
    float sum = 0.f, rmn = -INFINITY;
    int thr = qabs - 64 * (t + 1) - 4 * hi; asm volatile("" : "+v"(thr));
    if constexpr (DV == 64) {
    constexpr int NSG = DV / 64;
#pragma unroll
    for (int ks = 0; ks < 4; ++ks) {
        f32x16& src = (ks < 2) ? c0 : c1; const int base = (ks & 1) * 8;
        const v4u pw = (v4u){cvtpk_s(src[base], src[base + 1]), cvtpk_s(src[base + 2], src[base + 3]), cvtpk_s(src[base + 4], src[base + 5]), cvtpk_s(src[base + 6], src[base + 7])};
#pragma unroll
        for (int sg = 0; sg < NSG; ++sg) {
            s16x4 lo[2], hh[2];
#pragma unroll
            for (int e = 0; e < 2; ++e) { lo[e] = vtr(vb + (2 * sg + e) * 4096 + ks * 1024); hh[e] = vtr(vb + (2 * sg + e) * 4096 + ks * 1024 + 512); }
            ATT_FENCE();
            if (sg == 0 && ks < 3) { f32x16& nsrc = (ks + 1 < 2) ? c0 : c1; const int nbase = ((ks + 1) & 1) * 8;
#pragma unroll
                for (int j = 0; j < 8; ++j) nsrc[nbase + j] = __builtin_amdgcn_exp2f(nsrc[nbase + j]); }
            if (sg == NSG - 1) {
#pragma unroll
                for (int j = 0; j < 8; ++j) sum += src[base + j];
                f32x16& nx = (ks < 2) ? n0 : n1;
#pragma unroll
                for (int j = 0; j < 8; ++j) { const int r = base + j;
                    if (MASKN) { if ((r & 3) + 8 * (r >> 2) + ((ks < 2) ? 0 : 32) > thr) nx[r] = -INFINITY; }
                    rmn = fmaxf(rmn, nx[r]); } }
            ATT_FENCE();
#pragma unroll
            for (int e = 0; e < 2; ++e) { const bf16x8 vf = (bf16x8){lo[e][0], lo[e][1], lo[e][2], lo[e][3], hh[e][0], hh[e][1], hh[e][2], hh[e][3]};
                o[2 * sg + e] = __builtin_amdgcn_mfma_f32_32x32x16_bf16(__builtin_bit_cast(bf16x8, pw), vf, o[2 * sg + e], 0, 0, 0); }
            ATT_FENCE();
        }
    }
    } else {
#pragma unroll
    for (int ks = 0; ks < 4; ++ks) {
        f32x16& src = (ks < 2) ? c0 : c1; const int base = (ks & 1) * 8;
        const v4u pw = (v4u){cvtpk_s(src[base], src[base + 1]), cvtpk_s(src[base + 2], src[base + 3]), cvtpk_s(src[base + 4], src[base + 5]), cvtpk_s(src[base + 6], src[base + 7])};
#pragma unroll
        for (int d0 = 0; d0 < DV / 32; ++d0) { const s16x4 lo = vtr(vb + d0 * 4096 + ks * 1024), hh = vtr(vb + d0 * 4096 + ks * 1024 + 512);
            const bf16x8 vf = (bf16x8){lo[0], lo[1], lo[2], lo[3], hh[0], hh[1], hh[2], hh[3]};
            o[d0] = __builtin_amdgcn_mfma_f32_32x32x16_bf16(__builtin_bit_cast(bf16x8, pw), vf, o[d0], 0, 0, 0); }
        if (ks < 3) { f32x16& nsrc = (ks + 1 < 2) ? c0 : c1; const int nbase = ((ks + 1) & 1) * 8;
#pragma unroll
            for (int j = 0; j < 8; ++j) nsrc[nbase + j] = __builtin_amdgcn_exp2f(nsrc[nbase + j]); }
#pragma unroll
        for (int j = 0; j < 8; ++j) sum += src[base + j];
        { f32x16& nx = (ks < 2) ? n0 : n1;
#pragma unroll
          for (int j = 0; j < 8; ++j) { const int r = base + j;
              if (MASKN) { if ((r & 3) + 8 * (r >> 2) + ((ks < 2) ? 0 : 32) > thr) nx[r] = -INFINITY; }
              rmn = fmaxf(rmn, nx[r]); } }
        ATT_FENCE();
    }
    }
    l_run += sum;
    rm = max_halves(rmn);
}

template <int DQK, int DV, int NK1>
__device__ __forceinline__ void attn_core(const Src& s, int q0, char* shm, f32x16 (&o)[DV / 32], const int tid_in) {
    constexpr int THR = 8;
    const int tid = tid_in, lane = tid & 63, r32 = lane & 31, hi = lane >> 5; const int wid = __builtin_amdgcn_readfirstlane(tid >> 6);
    const unsigned lds0 = (unsigned)(uintptr_t)shm;
    LAS float* wsf = (LAS float*)((LAS char*)shm + L_WS) + wid * 64;
    constexpr int NKC = DQK / 8, NVP = DV / 8;
#define ATT_DMA_K(t, slot) do { \
        _Pragma("unroll") for (int c_ = 0; c_ < (NKC + 7) / 8; ++c_) { const int ch = wid + 8 * c_; if (ch < NKC) { \
            const bf16* src_ = (ch < NK1) ? s.K1 + (size_t)(64 * (t) + lane) * s.k1p + ch * 8 : s.K2 + (size_t)(64 * (t) + lane) * s.k2p + (ch - NK1) * 8; \
            glds16(src_, (unsigned)__builtin_amdgcn_readfirstlane(lds0 + L_K + (slot) * KSLOT + ch * 1024)); } } } while (0)
#define ATT_DMA_V(t, slot) do { \
        _Pragma("unroll") for (int c_ = 0; c_ < NVP / 8; ++c_) { const int p_ = wid + 8 * c_; const int db = p_ >> 2, rg = p_ & 3; \
            const bf16* src_ = s.V + (size_t)(64 * (t) + 16 * rg + (lane >> 2)) * s.vp + 32 * db + (lane & 3) * 8; \
            glds16(src_, (unsigned)__builtin_amdgcn_readfirstlane(lds0 + L_V + (slot) * VSLOT + p_ * 1024)); } } while (0)
#define ATT_BAR() asm volatile("s_waitcnt vmcnt(0) lgkmcnt(0)\n\ts_barrier" ::: "memory")
    ATT_DMA_K(0, 0); ATT_DMA_V(0, 0); ATT_DMA_K(1, 1);
    bf16x8 qr[DQK / 16];
#pragma unroll
    for (int d0 = 0; d0 < DQK / 16; ++d0) qr[d0] = *(const bf16x8*)(s.Q + (size_t)(q0 + wid * 32 + r32) * s.qp + d0 * 16 + hi * 8);
    float l_run = 0.f;
#pragma unroll
    for (int d = 0; d < DV / 32; ++d) o[d] = f32x16{};
    const int NT = (q0 + 256) / 64; const int qw0 = q0 + wid * 32, qabs = qw0 + r32;
    const int tlast = (qw0 + 31) >> 6;
    const lds_cptr kb0 = (lds_cptr)((LAS char*)shm) + L_K + hi * 1024 + r32 * 16;
    const lds_cptr vb0 = (lds_cptr)((LAS char*)shm) + L_V + ((lane >> 4) & 1) * 32 + (lane & 3) * 8 + (4 * hi + ((lane & 15) >> 2)) * 64;
    ATT_BAR();
    f32x16 a0, a1, b0_, b1_, negm; float rm, mhat;
    qk_tile<DQK>(kb0, qr, a0, a1);
    if (NT == 4) {
#pragma unroll
        for (int r = 0; r < 16; ++r) { const int thr0 = qabs - 4 * hi; if ((r & 3) + 8 * (r >> 2) > thr0) a0[r] = -INFINITY; if ((r & 3) + 8 * (r >> 2) + 32 > thr0) a1[r] = -INFINITY; }
    }
    { float v = fmaxf(a0[0], a1[0]);
#pragma unroll
      for (int r = 1; r < 16; ++r) v = fmaxf(v, fmaxf(a0[r], a1[r]));
      mhat = max_halves(v); rm = 0.f;
#pragma unroll
      for (int r = 0; r < 16; ++r) { a0[r] -= mhat; a1[r] -= mhat; negm[r] = -mhat; } }
    int t = 0;
    for (; t < NT - 6; t += 2) {
        ATT_BAR(); ATT_DMA_K(t + 2, 0); ATT_DMA_V(t + 1, 1);
        attn_step<DQK, DV, false, THR>(kb0 + KSLOT, vb0, qr, a0, a1, b0_, b1_, rm, negm, mhat, o, l_run, wsf, t, qabs, r32, hi);
        ATT_BAR(); ATT_DMA_K(t + 3, 1); ATT_DMA_V(t + 2, 0);
        attn_step<DQK, DV, false, THR>(kb0, vb0 + VSLOT, qr, b0_, b1_, a0, a1, rm, negm, mhat, o, l_run, wsf, t + 1, qabs, r32, hi);
    }
    for (; t < NT; t += 2) {
        ATT_BAR(); if (t + 2 < NT) ATT_DMA_K(t + 2, 0); ATT_DMA_V(t + 1, 1);
        if (t <= tlast) attn_step<DQK, DV, true, THR>(kb0 + KSLOT, vb0, qr, a0, a1, b0_, b1_, rm, negm, mhat, o, l_run, wsf, t, qabs, r32, hi);
        ATT_BAR(); if (t + 3 < NT) ATT_DMA_K(t + 3, 1); if (t + 2 < NT) ATT_DMA_V(t + 2, 0);
        if (t + 1 <= tlast) attn_step<DQK, DV, true, THR>(kb0, vb0 + VSLOT, qr, b0_, b1_, a0, a1, rm, negm, mhat, o, l_run, wsf, t + 1, qabs, r32, hi);
    }
#undef ATT_DMA_K
#undef ATT_DMA_V
#undef ATT_BAR
    l_run += shxl(l_run, 32, lane);
    if (hi == 0) wsf[32 + r32] = 1.0f / l_run;
#pragma unroll
    for (int k = 0; k < 4; ++k) { const f32x4 a = *(const LAS f32x4*)(wsf + 32 + 8 * k + 4 * hi);
#pragma unroll
        for (int d = 0; d < DV / 32; ++d) { o[d][4 * k] *= a[0]; o[d][4 * k + 1] *= a[1]; o[d][4 * k + 2] *= a[2]; o[d][4 * k + 3] *= a[3]; } }
}
}

#define RLX_AGENT __ATOMIC_RELAXED, __HIP_MEMORY_SCOPE_AGENT
#define XB_TMO      128
#define XB_XCNT(j)  (256  + 64 * (j))
#define XB_XSUB(j)  (1280 + 64 * (j))
#define XB_XGEN(j)  (2304 + 64 * (j))
#define XB_TOP      3328
#define XB_TOPGEN   3392
#define XCD_BAR_WORDS 3456
#define XB_SPIN_CAP (1u << 18)

__device__ __forceinline__ unsigned xb_ld(unsigned* p)              { return __hip_atomic_load(p, __ATOMIC_RELAXED, __HIP_MEMORY_SCOPE_AGENT); }
__device__ __forceinline__ unsigned xb_add(unsigned* p, unsigned v) { return __hip_atomic_fetch_add(p, v, __ATOMIC_RELAXED, __HIP_MEMORY_SCOPE_AGENT); }
__device__ __forceinline__ unsigned xb_xcc_id() { return (unsigned)__builtin_amdgcn_s_getreg((3 << 11) | 20) & 0xFu; }
#define XB_SPIN(cond, bar) do { unsigned _sp = 0; while (cond) { __builtin_amdgcn_s_sleep(1); \
    if ((++_sp & 255u) == 0u) { if (xb_ld(&(bar)[XB_TMO])) break; if (_sp > XB_SPIN_CAP) { atomicAdd(&(bar)[XB_TMO], 1u); break; } } } } while (0)

struct XcdBarrier {
    unsigned* bar; unsigned x;
    volatile LAS unsigned* st;
};

__device__ __forceinline__ XcdBarrier xcd_barrier_post(unsigned* bar, volatile LAS unsigned* st) {
    XcdBarrier b; b.bar = bar; b.x = xb_xcc_id(); b.st = st;
    if (threadIdx.x == 0) (void)xb_add(&bar[XB_XCNT(b.x)], 1u);
    return b;
}
__device__ __forceinline__ void xcd_barrier_complete(unsigned* bar, unsigned x, unsigned& nloc, unsigned& nx) {
    const unsigned G = gridDim.x * gridDim.y * gridDim.z;
    unsigned sum, cnt, mine, sp = 0u;
    for (;;) {
        sum = 0u; cnt = 0u; mine = 0u;
#pragma unroll
        for (unsigned j = 0; j < 16; ++j) { const unsigned c = xb_ld(&bar[XB_XCNT(j)]); sum += c; cnt += (c > 0u) ? 1u : 0u; mine = (j == x) ? c : mine; }
        if (sum == G) break;
        __builtin_amdgcn_s_sleep(1);
        if ((++sp & 255u) == 0u) { if (xb_ld(&bar[XB_TMO])) break; if (sp > XB_SPIN_CAP) { atomicAdd(&bar[XB_TMO], 1u); break; } }
    }
    nloc = mine > 0u ? mine : 1u; nx = cnt > 0u ? cnt : 1u;
}

__device__ __forceinline__ void xcd_barrier(const XcdBarrier b) {
    asm volatile("s_waitcnt vmcnt(0)" ::: "memory");
    __syncthreads();
    if (threadIdx.x == 0) {
        unsigned* bar = b.bar;
        __builtin_amdgcn_s_waitcnt(0);
        unsigned nloc = b.st[0], nx = b.st[1];
        if (nloc == 0u) { xcd_barrier_complete(bar, b.x, nloc, nx); b.st[0] = nloc; b.st[1] = nx; }
        const unsigned old = xb_add(&bar[XB_XSUB(b.x)], 1u);
        const unsigned gen = old / nloc;
        if (old + 1u == (gen + 1u) * nloc) {
            __builtin_amdgcn_fence(__ATOMIC_RELEASE, "agent");
            asm volatile("s_waitcnt vmcnt(0)" ::: "memory");
            const unsigned og = xb_add(&bar[XB_TOP], 1u);
            const unsigned tg = og / nx;
            if (og + 1u == (tg + 1u) * nx) xb_add(&bar[XB_TOPGEN], 1u);
            else XB_SPIN(xb_ld(&bar[XB_TOPGEN]) == tg, bar);
            __builtin_amdgcn_fence(__ATOMIC_ACQUIRE, "agent");
            xb_add(&bar[XB_XGEN(b.x)], 1u);
            asm volatile("s_waitcnt vmcnt(0)" ::: "memory");
        } else {
            XB_SPIN(xb_ld(&bar[XB_XGEN(b.x)]) == gen, bar);
            __builtin_amdgcn_fence(__ATOMIC_ACQUIRE, "agent");
            asm volatile("s_waitcnt vmcnt(0)" ::: "memory");
        }
    }
    __syncthreads();
}

__device__ __forceinline__ void p0_transpose_item(const float* W, const float* gain, int K, int N, bf16* WT, LAS float* scr, int item, int lane, int ldk = 0, int koff = 0, int nsc_from = 0x7fffffff) {
    if (ldk == 0) ldk = K;
    const int nblk = N / 32, kb = item / nblk, nb = item % nblk, k0 = 64 * kb, n0 = 32 * nb;
#pragma unroll 8
    for (int i = 0; i < 32; ++i) { const int kk = 2 * i + (lane >> 5); float v = __builtin_nontemporal_load(W + (size_t)(k0 + kk) * N + n0 + (lane & 31)); if (gain) v *= gain[k0 + kk]; if (n0 + (lane & 31) >= nsc_from) v *= NLOG2E; scr[kk * 33 + (lane & 31)] = v; }
    asm volatile("s_waitcnt lgkmcnt(0)" ::: "memory");
    const int c = lane & 7;
#pragma unroll
    for (int j = 0; j < 4; ++j) { const int n = (lane >> 3) + 8 * j; const LAS float* sp = scr + (8 * c) * 33 + n;
        v4u o; o.x = pk2(sp[0 * 33], sp[1 * 33]); o.y = pk2(sp[2 * 33], sp[3 * 33]); o.z = pk2(sp[4 * 33], sp[5 * 33]); o.w = pk2(sp[6 * 33], sp[7 * 33]);
        *(v4u*)(WT + (size_t)(n0 + n) * ldk + koff + k0 + 8 * c) = o; }
    asm volatile("s_waitcnt lgkmcnt(0)" ::: "memory");
}
__device__ __forceinline__ void sincos_red(float ang, float& c, float& sn) {
    const double rev = (double)ang * 0.15915494309189535; const float fr = (float)(rev - __builtin_rint(rev));
    c = __builtin_amdgcn_cosf(fr); sn = __builtin_amdgcn_sinf(fr);
}
template <int NR>
__device__ __forceinline__ void ln_rows_b(const bf16* src, bf16* d16, float* d32, size_t m0, size_t rstride, const float* g, const float* b, int lane) {
    v4u raw[NR][2]; f32x4 v[NR][4]; float mean[NR], rstd[NR];
#pragma unroll
    for (int i = 0; i < NR; ++i) { const bf16* r = src + (m0 + i * rstride) * 1024 + 8 * lane; if (d32) { raw[i][0] = __builtin_nontemporal_load((const v4u*)r); raw[i][1] = __builtin_nontemporal_load((const v4u*)(r + 512)); } else { raw[i][0] = *(const v4u*)r; raw[i][1] = *(const v4u*)(r + 512); } }
#pragma unroll
    for (int i = 0; i < NR; ++i) {
#pragma unroll
        for (int h = 0; h < 2; ++h) { const v4u w = raw[i][h];
            v[i][2 * h] = (f32x4){__builtin_bit_cast(float, w.x << 16), __builtin_bit_cast(float, w.x & 0xffff0000u), __builtin_bit_cast(float, w.y << 16), __builtin_bit_cast(float, w.y & 0xffff0000u)};
            v[i][2 * h + 1] = (f32x4){__builtin_bit_cast(float, w.z << 16), __builtin_bit_cast(float, w.z & 0xffff0000u), __builtin_bit_cast(float, w.w << 16), __builtin_bit_cast(float, w.w & 0xffff0000u)}; }
        float s = 0.f;
#pragma unroll
        for (int j = 0; j < 4; ++j) s += (v[i][j].x + v[i][j].y) + (v[i][j].z + v[i][j].w);
        mean[i] = wave_sum(s, lane) * (1.f / 1024.f); float s2 = 0.f;
#pragma unroll
        for (int j = 0; j < 4; ++j) { v[i][j] = v[i][j] - mean[i]; s2 += (v[i][j].x * v[i][j].x + v[i][j].y * v[i][j].y) + (v[i][j].z * v[i][j].z + v[i][j].w * v[i][j].w); }
        rstd[i] = 1.f / sqrtf(wave_sum(s2, lane) * (1.f / 1024.f) + LN_EPS); }
#pragma unroll
    for (int h = 0; h < 2; ++h) { const int c = 512 * h + 8 * lane;
        const f32x4 g0 = *(const f32x4*)(g + c), g1 = *(const f32x4*)(g + c + 4), b0 = *(const f32x4*)(b + c), b1 = *(const f32x4*)(b + c + 4);
#pragma unroll
        for (int i = 0; i < NR; ++i) { const f32x4 r0 = v[i][2 * h] * rstd[i] * g0 + b0, r1 = v[i][2 * h + 1] * rstd[i] * g1 + b1; const size_t off = (m0 + i * rstride) * 1024 + c;
            if (d16) *(v4u*)(d16 + off) = (v4u){pk2(r0.x, r0.y), pk2(r0.z, r0.w), pk2(r1.x, r1.y), pk2(r1.z, r1.w)};
            if (d32) { __builtin_nontemporal_store(r0, (f32x4*)(d32 + off)); __builtin_nontemporal_store(r1, (f32x4*)(d32 + off + 4)); } } }
}

__global__ void __launch_bounds__(NWAVES * 64, 2) mega_fwd(Params P_) {
    extern __shared__ __attribute__((aligned(16))) unsigned char lds[];
    cg::grid_group grid = cg::this_grid();
    const __attribute__((address_space(4))) Params* kp = (const __attribute__((address_space(4))) Params*)__builtin_amdgcn_kernarg_segment_ptr();
    asm volatile("" : "+s"(kp));
#define P (*kp)
    const int s_lo = P.s_lo, s_hi = P.s_hi;
    volatile LAS unsigned* const xb_st = (volatile LAS unsigned*)((LAS unsigned char*)lds + RING_BYTES + 64);
    if (s_hi - s_lo > 1) { if (threadIdx.x == 0) { xb_st[0] = 0u; xb_st[1] = 0u; } __syncthreads(); (void)xcd_barrier_post((unsigned*)(P.ws + WS_CTL), xb_st); }
    const int wave0 = __builtin_amdgcn_readfirstlane((int)threadIdx.x >> 6);
    for (int s = s_lo; s < s_hi; ++s) {
        int wv_ = wave0, bx_ = blockIdx.x, G_ = gridDim.x; asm volatile("" : "+s"(wv_), "+s"(bx_), "+s"(G_));
        const int wave = wv_;
#define LANE_ID() ({ int l_; asm volatile("v_mbcnt_lo_u32_b32 %0, -1, 0\n\tv_mbcnt_hi_u32_b32 %0, -1, %0" : "=v"(l_)); l_; })
        const int G = G_, bx = bx_, vcu = (G % 8 == 0) ? (bx % 8) * (G / 8) + bx / 8 : bx;
        unsigned char* const ws = P.ws;
        const int gw = vcu * NWAVES + wave, NGW = G * NWAVES;
        if (s == 0) {
            const int lane = LANE_ID(), tid = wave * 64 + lane;
            LAS float* scr = (LAS float*)((LAS unsigned char*)lds + wave * 16384);
            constexpr int I_IN = (1024 / 64) * (DIN / 32), I_UQ = (384 / 64) * (768 / 32), I_UKV = (256 / 64) * (1024 / 32), I_OD = (512 / 64) * (1024 / 32), I_OUT = (1024 / 64) * (1024 / 32),
                          I_UP = (1024 / 64) * (DFF / 32), I_DN = (DFF / 64) * (1024 / 32);
            constexpr int NITEMS = I_IN + I_UQ + I_UKV + 2 * I_OD + I_OUT + I_UP + I_DN;
            for (int it = gw; it < NITEMS; it += NGW) {
                int r = it;
                if (r < I_IN) { p0_transpose_item(P.w_in, nullptr, 1024, DIN, (bf16*)(ws + WS_WIN), scr, r, lane, 0, 0, 2208); continue; } r -= I_IN;
                if (r < I_UQ) { p0_transpose_item(P.w_uq, P.qn_g, 384, 768, (bf16*)(ws + WS_WUQ), scr, r, lane); continue; } r -= I_UQ;
                if (r < I_UKV) { p0_transpose_item(P.w_ukv, P.kvn_g, 256, 1024, (bf16*)(ws + WS_WUKV), scr, r, lane); continue; } r -= I_UKV;
                if (r < I_OD) { p0_transpose_item(P.w_od, nullptr, 512, 1024, (bf16*)(ws + WS_WOD), scr, r, lane, 1024, 0); continue; } r -= I_OD;
                if (r < I_OD) { p0_transpose_item(P.w_om, nullptr, 512, 1024, (bf16*)(ws + WS_WOD), scr, r, lane, 1024, 512); continue; } r -= I_OD;
                if (r < I_OUT) { p0_transpose_item(P.w_out, nullptr, 1024, 1024, (bf16*)(ws + WS_WOUT), scr, r, lane); continue; } r -= I_OUT;
                if (r < I_UP) { p0_transpose_item(P.w_up, nullptr, 1024, DFF, (bf16*)(ws + WS_WUP), scr, r, lane); continue; } r -= I_UP;
                p0_transpose_item(P.w_dn, nullptr, DFF, 1024, (bf16*)(ws + WS_WDN), scr, r, lane);
            }
            const int gt = vcu * (NWAVES * 64) + tid, NGT = G * NWAVES * 64;
            { v4u* z = (v4u*)(ws + WS_WIN + (size_t)DIN * 1024 * 2);
              for (int i = gt; i < (DINP - DIN) * 1024 * 2 / 16; i += NGT) { unsigned z_ = 0u; asm volatile("" : "+v"(z_)); z[i] = (v4u){z_, z_, z_, z_}; } }
            { const f32x4* xs = (const f32x4*)P.x; v4u* xd = (v4u*)(ws + WS_XB);
              for (int i = gt; i < NTOK * 1024 / 8; i += NGT) { const f32x4 a = __builtin_nontemporal_load(xs + 2 * i), b = __builtin_nontemporal_load(xs + 2 * i + 1); xd[i] = (v4u){pk2(a.x, a.y), pk2(a.z, a.w), pk2(b.x, b.y), pk2(b.z, b.w)}; } }
            { float* TD = (float*)(ws + WS_TD); float* TM = (float*)(ws + WS_TM);
              for (int i = gt; i < NTOK * 24; i += NGT) { const int tok = i / 24, j = i % 24; const float pf = (float)P.pos[tok];
                  if (j < 8) { const float inv = P.invf[j]; float c, sn; sincos_red(pf * inv, c, sn); TD[tok * 16 + j] = c; TD[tok * 16 + 8 + j] = sn; }
                  else { const int k = j - 8; const float inv = P.invf[j]; float c, sn; sincos_red(pf * inv, c, sn); TM[tok * 32 + k] = c; TM[tok * 32 + 16 + k] = sn; } } }
        } else if (s == 4) {
            const int lane = LANE_ID(), tid = wave * 64 + lane;
            char* shm = (char*)lds;
            const int r32 = lane & 31, hi = lane >> 5;
            float lamf;
            { const float* L = P.diff_lambda; const float a = wave_sum(L[lane] * L[64 + lane], lane), b = wave_sum(L[128 + lane] * L[192 + lane], lane); lamf = __expf(a) - __expf(b) + LAMBDA_INIT; }
            if (G == 256) {
                const int bh = vcu >> 2, sidx = vcu & 3, b = bh >> 2, h = bh & 3;
                const bf16* DQ = (const bf16*)(ws + WS_DQ) + (size_t)b * SEQ * 512 + h * 128; const bf16* DK = (const bf16*)(ws + WS_DK) + (size_t)b * SEQ * 512 + h * 128;
                const bf16* DV = (const bf16*)(ws + WS_DV) + (size_t)b * SEQ * 512 + h * 128; bf16* OD = (bf16*)(ws + WS_OD) + (size_t)b * SEQ * 1024 + h * 128;
                f32x4* scr1 = (f32x4*)(ws + WS_O1) + ((size_t)bx * 512 + tid) * 16;
                for (int i = 0; i < 4; ++i) {
                    const int qb = (i == 0) ? sidx : (i == 1) ? 7 - sidx : (i == 2) ? 8 + sidx : 15 - sidx; const int q0 = qb * 256;
                    for (int map = 0; map < 2; ++map) {
                        att::Src S{DQ + map * 64, 512, DK + map * 64, 512, DK, 512, DV, 512};
                        f32x16 o[4];
                        att::attn_core<64, 128, 8>(S, q0, shm, o, tid);
                        if (map == 0) {
#pragma unroll
                            for (int d = 0; d < 4; ++d)
#pragma unroll
                                for (int k = 0; k < 4; ++k) scr1[d * 4 + k] = (f32x4){o[d][4 * k], o[d][4 * k + 1], o[d][4 * k + 2], o[d][4 * k + 3]};
                        } else {
                            float ss[16];
#pragma unroll
                            for (int r = 0; r < 16; ++r) ss[r] = 0.f;
#pragma unroll
                            for (int d = 0; d < 4; ++d)
#pragma unroll
                                for (int k = 0; k < 4; ++k) { const f32x4 a = scr1[d * 4 + k];
#pragma unroll
                                    for (int j = 0; j < 4; ++j) { const float v = a[j] - lamf * o[d][4 * k + j]; o[d][4 * k + j] = v; ss[4 * k + j] += v * v; } }
#pragma unroll
                            for (int r = 0; r < 16; ++r) { float v = ss[r];
#pragma unroll
                                for (int mk = 1; mk < 32; mk <<= 1) v += shxl(v, mk, lane);
                                ss[r] = (1.0f / sqrtf(v * (1.f / 128.f) + RMS_EPS)) * (1.0f - LAMBDA_INIT); }
                            float gsub[4];
#pragma unroll
                            for (int d = 0; d < 4; ++d) gsub[d] = P.subln_g[32 * d + r32];
                            const int hi_e = LANE_ID() >> 5;
#pragma unroll
                            for (int r = 0; r < 16; ++r) { const int rr = att::crow(r, hi_e); bf16* op = OD + (size_t)(q0 + wave * 32 + rr) * 1024 + r32;
#pragma unroll
                                for (int d = 0; d < 4; ++d) op[32 * d] = (bf16)f2bf(o[d][r] * ss[r] * gsub[d]); }
                        }
                    }
                }
                {
                    const int bh2 = vcu >> 1, s2 = vcu & 1, b2 = bh2 >> 3, h2 = bh2 & 7;
                    const bf16* QM = (const bf16*)(ws + WS_QM) + (size_t)b2 * SEQ * 768 + h2 * 96; const bf16* KV = (const bf16*)(ws + WS_KV) + (size_t)b2 * SEQ * 1024 + h2 * 128;
                    const bf16* KR = (const bf16*)(ws + WS_KR) + (size_t)b2 * SEQ * 32; bf16* OM = (bf16*)(ws + WS_OD) + (size_t)b2 * SEQ * 1024 + 512 + h2 * 64;
                    for (int i = 0; i < 8; ++i) {
                        const int pr = i >> 1, qb = (i & 1) ? (4 * pr + 3 - s2) : (4 * pr + s2); const int q0 = qb * 256;
                        att::Src S{QM, 768, KV, 1024, KR, 32, KV + 64, 1024};
                        f32x16 o[2];
                        att::attn_core<96, 64, 8>(S, q0, shm, o, tid);
                        const int hi_e = LANE_ID() >> 5;
#pragma unroll
                        for (int r = 0; r < 16; ++r) { const int rr = att::crow(r, hi_e); bf16* op = OM + (size_t)(q0 + wave * 32 + rr) * 1024 + r32;
                            op[0] = (bf16)f2bf(o[0][r]); op[32] = (bf16)f2bf(o[1][r]); }
                    }
                }
            }
        } else if (s == 8 || s == 11) {
            const int lane = LANE_ID();
            bf16* const XB1 = (bf16*)(ws + WS_X1B);
            if (s == 8) { for (int m = gw; m < NTOK / 4; m += NGW) ln_rows_b<4>(XB1, XB1, nullptr, (size_t)m, (size_t)(NTOK / 4), P.ln1_g, P.ln1_b, lane); }
            else { for (int m = gw; m < NTOK / 4; m += NGW) ln_rows_b<4>(XB1, nullptr, P.out, (size_t)m, (size_t)(NTOK / 4), P.ln2_g, P.ln2_b, lane); }
        } else if (s == 6) {
        } else {
            const int tid = wave * 64 + LANE_ID();
            int mode; const bf16* A; const bf16* Bt; int N, K;
            switch (s) {
                case 1: mode = 0; A = (const bf16*)(ws + WS_XB); Bt = (const bf16*)(ws + WS_WIN); N = DINP; K = 1024; break;
                case 2: mode = 1; A = (const bf16*)(ws + WS_CQ); Bt = (const bf16*)(ws + WS_WUQ); N = 768; K = 384; break;
                case 3: mode = 2; A = (const bf16*)(ws + WS_CKV); Bt = (const bf16*)(ws + WS_WUKV); N = 1024; K = 256; break;
                case 5: mode = 3; A = (const bf16*)(ws + WS_OD); Bt = (const bf16*)(ws + WS_WOD); N = 1024; K = 1024; break;
                case 7: mode = 5; A = (const bf16*)(ws + WS_Y); Bt = (const bf16*)(ws + WS_WOUT); N = 1024; K = 1024; break;
                case 9: mode = 6; A = (const bf16*)(ws + WS_X1B); Bt = (const bf16*)(ws + WS_WUP); N = DFF; K = 1024; break;
                default: mode = 7; A = (const bf16*)(ws + WS_H); Bt = (const bf16*)(ws + WS_WDN); N = 1024; K = DFF; break;
            }
            if (mode == 0) { LAS float* gbl = (LAS float*)((LAS unsigned char*)lds + LH_GB); for (int i = tid; i < 2048; i += NWAVES * 64) gbl[i] = P.gate_b[i] * NLOG2E; __syncthreads(); }
            pg8::Gemm g{A, Bt, NTOK, N, K}; pg8::StaticOrder S; S.init(NTOK, N, G, bx);
            Epi E{mode, kp, (PG8_LAS unsigned char*)lds};
            pg8::gemm_phase<Epi, pg8::StaticOrder, true, true>((PG8_LAS unsigned char*)lds, g, S, E, tid);
        }
        if (s + 1 < s_hi) {
            const bool nosync = (s == 2 || s == 6);
            if (nosync) __syncthreads();
            else if (s_hi > 12) grid.sync();
            else { XcdBarrier xb; xb.bar = (unsigned*)(P.ws + WS_CTL); xb.x = xb_xcc_id(); xb.st = xb_st; xcd_barrier(xb); }
        }
    }
#undef P
#undef LANE_ID
}

#ifndef N_SPLIT
#define N_SPLIT 0
#endif
extern "C" void kernel_launch(void* const* d_in, const int* in_sizes, int n_in, void* d_out, int out_size, void* d_ws, size_t ws_size, hipStream_t stream) {
    static int grid = 0;
    if (grid == 0) {
        if (n_in != 19 || in_sizes[0] != NTOK * 1024 || out_size != NTOK * 1024 || ws_size < WS_END) { fprintf(stderr, "kernel_launch: unexpected shapes (n_in %d, ws %zu)\n", n_in, ws_size); grid = -1; return; }
        int dev = 0, cus = 0, per_cu = 0;
        hipGetDevice(&dev); hipDeviceGetAttribute(&cus, hipDeviceAttributeMultiprocessorCount, dev);
        if (hipFuncSetAttribute((const void*)mega_fwd, hipFuncAttributeMaxDynamicSharedMemorySize, LDS_BYTES) != hipSuccess) { fprintf(stderr, "kernel_launch: hipFuncSetAttribute failed\n"); grid = -1; return; }
        hipOccupancyMaxActiveBlocksPerMultiprocessor(&per_cu, (const void*)mega_fwd, NWAVES * 64, LDS_BYTES);
        (void)hipGetLastError();
        if (per_cu < 1 || cus < 256) fprintf(stderr, "kernel_launch: note: occupancy %d per CU, %d CUs\n", per_cu, cus);
        grid = 256;
    }
    if (grid < 0) return;
    Params p{};
    p.x = (const float*)d_in[0]; p.pos = (const int*)d_in[1]; p.w_in = (const float*)d_in[2]; p.gate_b = (const float*)d_in[3]; p.diff_lambda = (const float*)d_in[4]; p.subln_g = (const float*)d_in[5];
    p.qn_g = (const float*)d_in[6]; p.w_uq = (const float*)d_in[7]; p.kvn_g = (const float*)d_in[8]; p.w_ukv = (const float*)d_in[9]; p.w_od = (const float*)d_in[10]; p.w_om = (const float*)d_in[11];
    p.w_out = (const float*)d_in[12]; p.ln1_g = (const float*)d_in[13]; p.ln1_b = (const float*)d_in[14]; p.w_up = (const float*)d_in[15]; p.w_dn = (const float*)d_in[16]; p.ln2_g = (const float*)d_in[17]; p.ln2_b = (const float*)d_in[18];
    p.out = (float*)d_out; p.ws = (unsigned char*)d_ws;
    for (int j = 0; j < 8; ++j) p.invf[j] = (float)pow(500000.0, -(double)j / 8.0);
    for (int j = 0; j < 16; ++j) p.invf[8 + j] = (float)pow(500000.0, -(double)j / 16.0);
#if N_SPLIT
    const int cuts[11] = {0, 1, 2, 4, 5, 7, 8, 9, 10, 11, 12};
    for (int i = 0; i < 10; ++i) { p.s_lo = cuts[i]; p.s_hi = cuts[i + 1];
        hipLaunchKernelGGL(mega_fwd, dim3(grid), dim3(NWAVES * 64), LDS_BYTES, stream, p);
        const hipError_t le = hipPeekAtLastError(); if (le != hipSuccess) { fprintf(stderr, "kernel_launch: launch %d failed: %s\n", i, hipGetErrorName(le)); break; } }
#else
    p.s_lo = 0; p.s_hi = 12;
    if (hipMemsetAsync((char*)d_ws + WS_CTL, 0, CTL_BYTES, stream) != hipSuccess) { fprintf(stderr, "kernel_launch: hipMemsetAsync failed\n"); return; }
    void* args[] = {&p};
    const hipError_t e = hipLaunchCooperativeKernel((const void*)mega_fwd, dim3(grid), dim3(NWAVES * 64), args, LDS_BYTES, stream);
    if (e != hipSuccess) fprintf(stderr, "kernel_launch: cooperative launch failed: %s (grid %d)\n", hipGetErrorString(e), grid);
#endif
}
```
